# Optimizing an MI355X kernel written in HIP

```python
import jax, jax.numpy as jnp
from jax import lax
import numpy as np

D_MODEL = 4096
BATCH = 4
SEQ = 2048
DEPTH = 1

HEAD_DIM = 128
N_HEADS = D_MODEL // (2 * HEAD_DIM)
N_KV_HEADS = N_HEADS // 4
GQA_GROUP = N_HEADS // N_KV_HEADS
ATTN_WIDTH = N_HEADS * HEAD_DIM
KV_WIDTH = N_KV_HEADS * HEAD_DIM
WINDOW = 128
BLOCK = 128
ROPE_THETA = 10000.0
POOL_WIDTH = D_MODEL - ATTN_WIDTH
POOL_WINDOWS = (2, 4, 8, 16)
N_POOL_GROUPS = len(POOL_WINDOWS)
POOL_GROUP_WIDTH = POOL_WIDTH // N_POOL_GROUPS
MIX_WIDTH = ATTN_WIDTH + POOL_WIDTH
IN_PROJ_WIDTH = ATTN_WIDTH + 2 * KV_WIDTH + POOL_WIDTH
D_FF = ((8 * D_MODEL // 3 + 255) // 256) * 256
FFN_RES_WEIGHT = 0.5
RMS_EPS = 1e-6

kernel_name = "hymba_swa_sink_pool_macaron"


def rmsnorm(x, g):
    xf = x.astype(jnp.float32)
    y = xf * lax.rsqrt(jnp.mean(xf * xf, axis=-1, keepdims=True) + RMS_EPS)
    return (y * g.astype(jnp.float32)).astype(x.dtype)


def swiglu(h, w_gate, w_up, w_down):
    return (jax.nn.silu(h @ w_gate) * (h @ w_up)) @ w_down


def rope(t):
    s = t.shape[1]
    pos = jnp.arange(s, dtype=jnp.float32)
    inv_freq = ROPE_THETA ** (-jnp.arange(0, HEAD_DIM, 2, dtype=jnp.float32) / HEAD_DIM)
    ang = pos[:, None] * inv_freq[None, :]
    cos = jnp.cos(ang)[None, :, None, :]
    sin = jnp.sin(ang)[None, :, None, :]
    tf = t.astype(jnp.float32)
    t1, t2 = tf[..., : HEAD_DIM // 2], tf[..., HEAD_DIM // 2:]
    out = jnp.concatenate([t1 * cos - t2 * sin, t2 * cos + t1 * sin], axis=-1)
    return out.astype(t.dtype)


def sliding_window_attention(q, k, v, sinks):
    b, s = q.shape[0], q.shape[1]
    nb = s // BLOCK
    qb = q.reshape(b, nb, BLOCK, N_KV_HEADS, GQA_GROUP, HEAD_DIM)

    def with_prev(t):
        t = t.reshape(b, nb, BLOCK, N_KV_HEADS, HEAD_DIM)
        prev = jnp.concatenate([jnp.zeros_like(t[:, :1]), t[:, :-1]], axis=1)
        return jnp.concatenate([prev, t], axis=2)

    kb, vb = with_prev(k), with_prev(v)
    scale = HEAD_DIM ** -0.5
    sc = jnp.einsum('bnqhgd,bnkhd->bhgnqk', qb, kb,
                    preferred_element_type=jnp.float32) * scale
    qi = jnp.arange(BLOCK)[:, None]
    ki = jnp.arange(2 * BLOCK)[None, :]
    diff = qi + BLOCK - ki
    band = (diff >= 0) & (diff < WINDOW)
    blk = jnp.arange(nb)[:, None, None]
    valid = band[None] & ((blk > 0) | (ki >= BLOCK)[None])
    sc = jnp.where(valid[None, None, None], sc, -jnp.inf)
    sink = sinks.astype(jnp.float32).reshape(N_KV_HEADS, GQA_GROUP)[None, :, :, None, None, None]
    m = jnp.maximum(jnp.max(sc, axis=-1, keepdims=True), sink)
    e = jnp.exp(sc - m)
    denom = jnp.sum(e, axis=-1, keepdims=True) + jnp.exp(sink - m)
    p = (e / denom).astype(vb.dtype)
    out = jnp.einsum('bhgnqk,bnkhd->bnqhgd', p, vb)
    return out.reshape(b, s, ATTN_WIDTH)


def multiscale_pool(p, pool_w, pool_scale):
    b, s = p.shape[0], p.shape[1]
    pg = p.reshape(b, s, N_POOL_GROUPS, POOL_GROUP_WIDTH).astype(jnp.float32)
    c = jnp.cumsum(pg, axis=1)
    c0 = jnp.concatenate([jnp.zeros_like(c[:, :1]), c], axis=1)
    t = jnp.arange(s)
    outs = []
    for g, w in enumerate(POOL_WINDOWS):
        cg = c0[:, :, g, :]
        lo = jnp.maximum(t + 1 - w, 0)
        win_sum = cg[:, 1:] - jnp.take(cg, lo, axis=1)
        count = jnp.minimum(t + 1, w).astype(jnp.float32)[None, :, None]
        outs.append(win_sum / count)
    pooled = jnp.stack(outs, axis=2)
    y = (pooled - pg).astype(p.dtype)
    y = jnp.einsum('bsgc,gcd->bsgd', y, pool_w).reshape(b, s, POOL_WIDTH)
    return y * pool_scale


def setup_inputs(seed: int = 0) -> dict:
    key = jax.random.key(seed)
    ks = jax.random.split(key, 20)
    f32 = jnp.float32

    def w(k, shape, fan_in):
        return jax.random.normal(k, shape, f32) * fan_in ** -0.5

    def gain(k, shape):
        return 1.0 + 0.05 * jax.random.normal(k, shape, f32)

    L = DEPTH
    return {
        "x": jax.random.normal(ks[0], (BATCH, SEQ, D_MODEL), f32),
        "ffn1_pre_g": gain(ks[1], (L, D_MODEL)),
        "ffn1_w_gate": w(ks[2], (L, D_MODEL, D_FF), D_MODEL),
        "ffn1_w_up": w(ks[3], (L, D_MODEL, D_FF), D_MODEL),
        "ffn1_w_down": w(ks[4], (L, D_FF, D_MODEL), D_FF),
        "ffn1_post_g": gain(ks[5], (L, D_MODEL)),
        "mix_pre_g": gain(ks[6], (L, D_MODEL)),
        "w_in": w(ks[7], (L, D_MODEL, IN_PROJ_WIDTH), D_MODEL),
        "attn_sinks": jax.random.normal(ks[8], (L, N_HEADS), f32),
        "pool_w": w(ks[9], (L, N_POOL_GROUPS, POOL_GROUP_WIDTH, POOL_GROUP_WIDTH), POOL_GROUP_WIDTH),
        "pool_scale": gain(ks[10], (L, POOL_WIDTH)),
        "w_out": w(ks[11], (L, MIX_WIDTH, D_MODEL), MIX_WIDTH),
        "mix_post_g": gain(ks[12], (L, D_MODEL)),
        "ffn2_pre_g": gain(ks[13], (L, D_MODEL)),
        "ffn2_w_gate": w(ks[14], (L, D_MODEL, D_FF), D_MODEL),
        "ffn2_w_up": w(ks[15], (L, D_MODEL, D_FF), D_MODEL),
        "ffn2_w_down": w(ks[16], (L, D_FF, D_MODEL), D_FF),
        "ffn2_post_g": gain(ks[17], (L, D_MODEL)),
    }


def reference(x, ffn1_pre_g, ffn1_w_gate, ffn1_w_up, ffn1_w_down, ffn1_post_g,
              mix_pre_g, w_in, attn_sinks, pool_w, pool_scale, w_out, mix_post_g,
              ffn2_pre_g, ffn2_w_gate, ffn2_w_up, ffn2_w_down, ffn2_post_g):
    b, s = x.shape[0], x.shape[1]
    for l in range(DEPTH):
        h = swiglu(rmsnorm(x, ffn1_pre_g[l]), ffn1_w_gate[l], ffn1_w_up[l], ffn1_w_down[l])
        x = x + FFN_RES_WEIGHT * rmsnorm(h, ffn1_post_g[l])

        h = rmsnorm(x, mix_pre_g[l])
        proj = h @ w_in[l]
        q = proj[..., :ATTN_WIDTH]
        k = proj[..., ATTN_WIDTH:ATTN_WIDTH + KV_WIDTH]
        v = proj[..., ATTN_WIDTH + KV_WIDTH:ATTN_WIDTH + 2 * KV_WIDTH]
        p = proj[..., ATTN_WIDTH + 2 * KV_WIDTH:]
        q = rope(q.reshape(b, s, N_HEADS, HEAD_DIM))
        k = rope(k.reshape(b, s, N_KV_HEADS, HEAD_DIM))
        v = v.reshape(b, s, N_KV_HEADS, HEAD_DIM)
        a = sliding_window_attention(q, k, v, attn_sinks[l])
        pm = multiscale_pool(p, pool_w[l], pool_scale[l])
        y = jnp.concatenate([a, pm], axis=-1) @ w_out[l]
        x = x + rmsnorm(y, mix_post_g[l])

        h = swiglu(rmsnorm(x, ffn2_pre_g[l]), ffn2_w_gate[l], ffn2_w_up[l], ffn2_w_down[l])
        x = x + FFN_RES_WEIGHT * rmsnorm(h, ffn2_post_g[l])
    return x
```

```cpp
#include <hip/hip_runtime.h>
#include <cstdio>
#include <cstdint>

#ifndef MK_SPLIT
#define MK_SPLIT 0
#endif

namespace pg8 {
#define PG8_LAS __attribute__((address_space(3)))
typedef unsigned short bf16_t;
typedef short bf16x8 __attribute__((ext_vector_type(8)));
typedef float f32x4 __attribute__((ext_vector_type(4)));
typedef unsigned u32x4 __attribute__((ext_vector_type(4)));
constexpr int BM = 256, BK = 64, HALF = 128, HTB = HALF * BK * 2  , STAGE_BYTES = 8 * HTB, NXCD = 8, WGM = 8;

__host__ __device__ __forceinline__ int lds_byte(int r, int c) { const int st = (r >> 4) * 2 + (c >> 5), rr = r & 15, cc = c & 31, ob = rr * 64 + cc * 2; return st * 1024 + (ob ^ (((ob >> 9) & 1) << 5)); }
__host__ __device__ __forceinline__ void stage_rc(int b, int& R, int& C) { const int st = b / 1024, sb = b % 1024, swz = sb ^ (((sb >> 9) & 1) << 5); R = (st >> 1) * 16 + swz / 64; C = (st & 1) * 32 + (swz % 64) / 2; }
__host__ __device__ __forceinline__ int perm32(int rho) { const int n = rho >> 4, i = rho & 15; return 8 * (i >> 2) + 4 * n + (i & 3); }

struct Unit { int pm, pn; };
struct Gemm { const bf16_t* A; const bf16_t* Bt; int M, N, K, lda, ldb, a_shift, a_step; };

struct StaticOrder {
    int nM, nN, nwg, G, c;
    __host__ __device__ void init(int M, int N, int G_, int c_) { nM = M / BM; nN = N / BM; nwg = nM * nN; G = G_; c = c_; }
    __host__ __device__ bool next(int i, Unit& u) const {
        const long L = (long)i * G + c; if (L >= nwg) return false;
        int wgid = (int)L; { const int q = nwg / NXCD, r = nwg % NXCD, xcd = wgid % NXCD, off = wgid / NXCD; wgid = (xcd < r ? xcd * (q + 1) : r * (q + 1) + (xcd - r) * q) + off; }
        const int nig = WGM * nN, gid = wgid / nig, fm = gid * WGM, gsz = (nM - fm) < WGM ? (nM - fm) : WGM;
        u.pm = fm + ((wgid % nig) % gsz); u.pn = (wgid % nig) / gsz; return true;
    }
    __device__ __forceinline__ void a_ready(const Unit&) const {}
    __device__ __forceinline__ void done(const Unit&) const {}
};

__device__ __forceinline__ unsigned cvt_pk_bf16(float lo, float hi) { unsigned r; asm volatile("v_cvt_pk_bf16_f32 %0, %1, %2" : "=v"(r) : "v"(lo), "v"(hi)); return r; }
__device__ __forceinline__ u32x4 pack8(const f32x4 a, const f32x4 b) { u32x4 w; w.x = cvt_pk_bf16(a[0], a[1]); w.y = cvt_pk_bf16(a[2], a[3]); w.z = cvt_pk_bf16(b[0], b[1]); w.w = cvt_pk_bf16(b[2], b[3]); return w; }

struct EpiF32 {
    static constexpr bool PERM = false;
    float* C; int ldc;
    __device__ __forceinline__ void operator()(const f32x4 (&acc)[2][2][4][2], const Unit& u, int wr, int wc, int fr, int fq) const {
        const int row0 = u.pm * BM + wr * 64 + fr, col0 = u.pn * BM + wc * 32 + 4 * fq;
#pragma unroll
        for (int ai = 0; ai < 2; ++ai)
#pragma unroll
            for (int m = 0; m < 4; ++m) { float* rowp = C + (size_t)(row0 + ai * HALF + m * 16) * ldc + col0;
#pragma unroll
                for (int bj = 0; bj < 2; ++bj)
#pragma unroll
                    for (int n = 0; n < 2; ++n) *(f32x4*)(rowp + bj * HALF + n * 16) = acc[ai][bj][m][n]; }
    }
};
struct EpiBf16 {
    static constexpr bool PERM = true;
    bf16_t* O; int ldc;
    __device__ __forceinline__ void operator()(const f32x4 (&acc)[2][2][4][2], const Unit& u, int wr, int wc, int fr, int fq) const {
        const int row0 = u.pm * BM + wr * 64 + fr, col0 = u.pn * BM + wc * 32 + 8 * fq;
#pragma unroll
        for (int ai = 0; ai < 2; ++ai)
#pragma unroll
            for (int m = 0; m < 4; ++m) { bf16_t* rowp = O + (size_t)(row0 + ai * HALF + m * 16) * ldc + col0;
#pragma unroll
                for (int bj = 0; bj < 2; ++bj) *(u32x4*)(rowp + bj * HALF) = pack8(acc[ai][bj][m][0], acc[ai][bj][m][1]); }
    }
};
__device__ __forceinline__ float silu_f(float x) { return x * __builtin_amdgcn_rcpf(1.0f + __builtin_amdgcn_exp2f(-1.44269504089f * x)); }
struct EpiSwiGLU {
    static constexpr bool PERM = true;
    bf16_t* O; int ldc;
    __device__ __forceinline__ void operator()(const f32x4 (&acc)[2][2][4][2], const Unit& u, int wr, int wc, int fr, int fq) const {
        const int row0 = u.pm * BM + wr * 64 + fr, col0 = u.pn * HALF + wc * 32 + 8 * fq;
#pragma unroll
        for (int ai = 0; ai < 2; ++ai)
#pragma unroll
            for (int m = 0; m < 4; ++m) { bf16_t* rowp = O + (size_t)(row0 + ai * HALF + m * 16) * ldc + col0;
                f32x4 v0, v1;
#pragma unroll
                for (int e = 0; e < 4; ++e) { v0[e] = silu_f(acc[ai][0][m][0][e]) * acc[ai][1][m][0][e]; v1[e] = silu_f(acc[ai][0][m][1][e]) * acc[ai][1][m][1][e]; }
                *(u32x4*)rowp = pack8(v0, v1); }
    }
};
struct EpiInProj {
    static constexpr bool PERM = true;
    bf16_t* O; int ldc; const float* cs; const float* sn;
    __device__ __forceinline__ void operator()(const f32x4 (&acc)[2][2][4][2], const Unit& u, int wr, int wc, int fr, int fq) const {
        const int row0 = u.pm * BM + wr * 64 + fr;
        if (u.pn < 10) {
            const int hsel = wc >> 1, ii0 = 32 * (wc & 1) + 8 * fq, col0 = u.pn * BM + 128 * hsel + ii0;
#pragma unroll
            for (int ai = 0; ai < 2; ++ai)
#pragma unroll
                for (int m = 0; m < 4; ++m) { const int row = row0 + ai * HALF + m * 16, pos = row & 2047; bf16_t* rowp = O + (size_t)row * ldc + col0;
                    const f32x4 c0 = *(const f32x4*)(cs + pos * 64 + ii0), c1 = *(const f32x4*)(cs + pos * 64 + ii0 + 4), s0 = *(const f32x4*)(sn + pos * 64 + ii0), s1 = *(const f32x4*)(sn + pos * 64 + ii0 + 4);
                    const f32x4 a0 = acc[ai][0][m][0], a1 = acc[ai][0][m][1], b0 = acc[ai][1][m][0], b1 = acc[ai][1][m][1];
                    *(u32x4*)rowp = pack8(a0 * c0 - b0 * s0, a1 * c1 - b1 * s1);
                    *(u32x4*)(rowp + 64) = pack8(b0 * c0 + a0 * s0, b1 * c1 + a1 * s1); }
        } else {
            const int col0 = u.pn * BM + wc * 32 + 8 * fq;
#pragma unroll
            for (int ai = 0; ai < 2; ++ai)
#pragma unroll
                for (int m = 0; m < 4; ++m) { bf16_t* rowp = O + (size_t)(row0 + ai * HALF + m * 16) * ldc + col0;
#pragma unroll
                    for (int bj = 0; bj < 2; ++bj) *(u32x4*)(rowp + bj * HALF) = pack8(acc[ai][bj][m][0], acc[ai][bj][m][1]); }
        }
    }
};
struct EpiPool {
    static constexpr bool PERM = true;
    bf16_t* O; int ldc; const float* scale;
    __device__ __forceinline__ void operator()(const f32x4 (&acc)[2][2][4][2], const Unit& u, int wr, int wc, int fr, int fq) const {
        const int row0 = u.pm * BM + wr * 64 + fr, col0 = u.pn * BM + wc * 32 + 8 * fq;
        f32x4 sv[2][2];
#pragma unroll
        for (int bj = 0; bj < 2; ++bj) { sv[bj][0] = *(const f32x4*)(scale + col0 + bj * HALF); sv[bj][1] = *(const f32x4*)(scale + col0 + bj * HALF + 4); }
#pragma unroll
        for (int ai = 0; ai < 2; ++ai)
#pragma unroll
            for (int m = 0; m < 4; ++m) { bf16_t* rowp = O + (size_t)(row0 + ai * HALF + m * 16) * ldc + col0;
#pragma unroll
                for (int bj = 0; bj < 2; ++bj) *(u32x4*)(rowp + bj * HALF) = pack8(acc[ai][bj][m][0] * sv[bj][0], acc[ai][bj][m][1] * sv[bj][1]); }
    }
};

struct DownOrder {
    StaticOrder base; bool special;
    __host__ __device__ void init(int M, int N, int G_, int c_) { base.init(M, N, G_, c_); special = (G_ == 256 && base.nM == 32 && base.nN == 16); }
    __host__ __device__ bool next(int i, Unit& u) const {
        if (!special) return base.next(i, u);
        if (i >= 2) return false;
        const int xcd = base.c & 7, off = base.c >> 3;
        u.pm = 8 * (xcd >> 1) + 4 * i + (off & 3); u.pn = 8 * (xcd & 1) + (off >> 2); return true;
    }
    __device__ __forceinline__ void a_ready(const Unit&) const {}
    __device__ __forceinline__ void done(const Unit&) const {}
};
struct EpiFinalNorm {
    static constexpr bool PERM = false;
    const bf16_t* xres; const float* gain; float* out; float* rowsum; unsigned* cnt; unsigned* tmo; int ldc; float w, eps;
    __device__ __forceinline__ void operator()(const f32x4 (&acc)[2][2][4][2], const Unit& u, int wr, int wc, int fr, int fq) const {
        const int row0 = u.pm * BM + wr * 64 + fr, col0 = u.pn * BM + wc * 32 + 4 * fq;
#pragma unroll
        for (int ai = 0; ai < 2; ++ai)
#pragma unroll
            for (int m = 0; m < 4; ++m) {
                float s = 0.f;
#pragma unroll
                for (int bj = 0; bj < 2; ++bj)
#pragma unroll
                    for (int n = 0; n < 2; ++n) { const f32x4 x = acc[ai][bj][m][n]; s += (x[0] * x[0] + x[1] * x[1]) + (x[2] * x[2] + x[3] * x[3]); }
                s += __shfl_xor(s, 16); s += __shfl_xor(s, 32);
                if (fq == 0) (void)__hip_atomic_fetch_add(rowsum + row0 + ai * HALF + m * 16, s, __ATOMIC_RELAXED, __HIP_MEMORY_SCOPE_AGENT);
            }
        asm volatile("s_waitcnt vmcnt(0)" ::: "memory");
        if (fq == 0 && fr == 0) (void)__hip_atomic_fetch_add(cnt + 64 * u.pm, 1u, __ATOMIC_RELAXED, __HIP_MEMORY_SCOPE_AGENT);
        if (wr == 0 && wc == 0) {
            unsigned spins = 0;
            while ((unsigned)__builtin_amdgcn_readfirstlane(__hip_atomic_load(cnt + 64 * u.pm, __ATOMIC_RELAXED, __HIP_MEMORY_SCOPE_AGENT)) < 128u) {
                __builtin_amdgcn_s_sleep(1);
                if ((++spins & 255u) == 0u) { if (__hip_atomic_load(tmo, __ATOMIC_RELAXED, __HIP_MEMORY_SCOPE_AGENT) != 0u) break; if (spins > (1u << 18)) { __hip_atomic_store(tmo, 1u, __ATOMIC_RELAXED, __HIP_MEMORY_SCOPE_AGENT); break; } }
            }
        }
        asm volatile("" ::: "memory"); __builtin_amdgcn_s_barrier(); asm volatile("" ::: "memory");
        float rs[2][4];
#pragma unroll
        for (int ai = 0; ai < 2; ++ai)
#pragma unroll
            for (int m = 0; m < 4; ++m) rs[ai][m] = w / sqrtf(__hip_atomic_load(rowsum + row0 + ai * HALF + m * 16, __ATOMIC_RELAXED, __HIP_MEMORY_SCOPE_AGENT) * (1.0f / 4096.0f) + eps);
        f32x4 gv[2][2];
#pragma unroll
        for (int bj = 0; bj < 2; ++bj)
#pragma unroll
            for (int n = 0; n < 2; ++n) gv[bj][n] = *(const f32x4*)(gain + col0 + bj * HALF + n * 16);
        typedef unsigned u32x2v __attribute__((ext_vector_type(2)));
#pragma unroll
        for (int ai = 0; ai < 2; ++ai)
#pragma unroll
            for (int m = 0; m < 4; ++m) { const size_t off = (size_t)(row0 + ai * HALF + m * 16) * ldc + col0; const float r = rs[ai][m];
#pragma unroll
                for (int bj = 0; bj < 2; ++bj)
#pragma unroll
                    for (int n = 0; n < 2; ++n) { const u32x2v q = *(const u32x2v*)(xres + off + bj * HALF + n * 16);
                        const f32x4 xv = (f32x4){__builtin_bit_cast(float, q.x << 16), __builtin_bit_cast(float, q.x & 0xffff0000u), __builtin_bit_cast(float, q.y << 16), __builtin_bit_cast(float, q.y & 0xffff0000u)};
                        *(f32x4*)(out + off + bj * HALF + n * 16) = xv + acc[ai][bj][m][n] * r * gv[bj][n]; } }
    }
};

template <class Epi, class Sched>
__device__ __forceinline__ void gemm_phase(PG8_LAS unsigned char* lds, const Gemm g, const Sched& S, const Epi& E, const int wid, const int lane) {
    const int tid = wid * 64 + lane, wr = wid >> 2, wc = wid & 3, fr = lane & 15, fq = lane >> 4;
    const int K = g.K, nt = K / BK;
    unsigned voffA[2], voffB[2];
#pragma unroll
    for (int i = 0; i < 2; ++i) { int R, C; stage_rc(tid * 16 + i * 8192, R, C); const int Rb = Epi::PERM ? ((R & ~31) + perm32(R & 31)) : R;
        voffA[i] = (unsigned)(R * g.lda + C) * 2u; voffB[i] = (unsigned)(Rb * g.ldb + C) * 2u; }
    const size_t kstep = (size_t)(BK * 2);
    const size_t hstepA = (size_t)HALF * g.lda * 2, hstepB = (size_t)HALF * g.ldb * 2;
    const size_t tstepA = 2 * hstepA, tstepB = 2 * hstepB;
    const unsigned ldsw = (unsigned)wid * 1024u;
    const int aoff = lds_byte(wr * 64 + fr, fq * 8), boff = lds_byte(wc * 32 + fr, fq * 8);
#define PG8_SA(b, h) (((b) * 2 + (h)) * HTB)
#define PG8_SB(b, h) ((4 + (b) * 2 + (h)) * HTB)
#define PG8_STAGE(bufoff, gbase, voff) do { _Pragma("unroll") for (int _i = 0; _i < 2; ++_i) \
        __builtin_amdgcn_global_load_lds((const unsigned*)((const char*)(gbase) + (voff)[_i]), (PG8_LAS unsigned*)(lds + (bufoff) + ldsw + _i * 8192), 16, 0, 0); } while (0)
#define PG8_LDA(dst, b, h) do { _Pragma("unroll") for (int m = 0; m < 4; ++m) _Pragma("unroll") for (int k = 0; k < 2; ++k) dst[m][k] = *(const PG8_LAS bf16x8*)(lds + PG8_SA(b, h) + aoff + m * 2048 + k * 1024); } while (0)
#define PG8_LDB(dst, b, h) do { _Pragma("unroll") for (int n = 0; n < 2; ++n) _Pragma("unroll") for (int k = 0; k < 2; ++k) dst[n][k] = *(const PG8_LAS bf16x8*)(lds + PG8_SB(b, h) + boff + n * 2048 + k * 1024); } while (0)
#define PG8_MMA(ai, bj, At, Bt) do { __builtin_amdgcn_s_setprio(1); _Pragma("unroll") for (int m = 0; m < 4; ++m) _Pragma("unroll") for (int n = 0; n < 2; ++n) _Pragma("unroll") for (int k = 0; k < 2; ++k) \
        acc[ai][bj][m][n] = __builtin_amdgcn_mfma_f32_16x16x32_bf16(Bt[n][k], At[m][k], acc[ai][bj][m][n], 0, 0, 0); __builtin_amdgcn_s_setprio(0); } while (0)
#define PG8_WAIT_V(n) asm volatile("s_waitcnt vmcnt(" #n ")" ::: "memory")
#define PG8_WAIT_L(n) asm volatile("s_waitcnt lgkmcnt(" #n ")" ::: "memory")
#define PG8_BAR __builtin_amdgcn_s_barrier()
#define PG8_SCHED __builtin_amdgcn_sched_barrier(0)
    Unit cur, nxt; int ui = 0;
    if (!S.next(0, cur)) return;
    f32x4 acc[2][2][4][2];
#pragma unroll
    for (int a = 0; a < 2; ++a)
#pragma unroll
        for (int b = 0; b < 2; ++b)
#pragma unroll
            for (int m = 0; m < 4; ++m)
#pragma unroll
                for (int n = 0; n < 2; ++n) acc[a][b][m][n] = (f32x4){0.f, 0.f, 0.f, 0.f};
    bf16x8 At[4][2], B0[2][2], B1[2][2];
    const char* cA = (const char*)g.A + (size_t)cur.pm * tstepA + (size_t)((cur.pn >> g.a_shift) * g.a_step) * 2; const char* cB = (const char*)g.Bt + (size_t)cur.pn * tstepB;
    S.a_ready(cur);
    PG8_STAGE(PG8_SB(0, 0), cB, voffB); PG8_STAGE(PG8_SB(0, 1), cB + hstepB, voffB); PG8_STAGE(PG8_SA(0, 0), cA, voffA); PG8_STAGE(PG8_SA(0, 1), cA + hstepA, voffA);
    if (wr == 1) PG8_BAR;
    PG8_WAIT_V(2); PG8_BAR;
    PG8_STAGE(PG8_SB(1, 0), cB + kstep, voffB); PG8_STAGE(PG8_SA(1, 0), cA + kstep, voffA); PG8_STAGE(PG8_SB(1, 1), cB + hstepB + kstep, voffB);
    PG8_WAIT_V(6); PG8_BAR;
    for (;;) {
        const bool has_next = S.next(ui + 1, nxt);
        const char* nA = has_next ? (const char*)g.A + (size_t)nxt.pm * tstepA + (size_t)((nxt.pn >> g.a_shift) * g.a_step) * 2 : cA; const char* nB = has_next ? (const char*)g.Bt + (size_t)nxt.pn * tstepB : cB;
        for (int t = 0; t < nt; t += 2) {
            const bool last = (t == nt - 2);
            const char* a1 = cA + (size_t)(t + 1) * kstep;
            const char* a2 = last ? nA : cA + (size_t)(t + 2) * kstep; const char* b2 = last ? nB : cB + (size_t)(t + 2) * kstep;
            const char* a3 = a2 + kstep; const char* b3 = b2 + kstep;
            if (last && has_next) S.a_ready(nxt);
            PG8_LDB(B0, 0, 0); PG8_LDB(B1, 0, 1); PG8_SCHED; PG8_LDA(At, 0, 0); PG8_STAGE(PG8_SA(1, 1), a1 + hstepA, voffA);
            PG8_WAIT_V(8); PG8_WAIT_L(0); PG8_BAR; PG8_MMA(0, 0, At, B0); PG8_MMA(0, 1, At, B1); PG8_BAR; PG8_SCHED;
            PG8_LDA(At, 0, 1); PG8_STAGE(PG8_SB(0, 0), b2, voffB); PG8_STAGE(PG8_SB(0, 1), b2 + hstepB, voffB); PG8_STAGE(PG8_SA(0, 0), a2, voffA);
            PG8_WAIT_V(8); PG8_WAIT_L(0); PG8_BAR; PG8_MMA(1, 0, At, B0); PG8_MMA(1, 1, At, B1); PG8_BAR; PG8_SCHED;
            PG8_LDB(B0, 1, 0); PG8_LDB(B1, 1, 1); PG8_SCHED; PG8_LDA(At, 1, 0); PG8_STAGE(PG8_SA(0, 1), a2 + hstepA, voffA);
            PG8_WAIT_V(8); PG8_WAIT_L(0); PG8_BAR; PG8_MMA(0, 0, At, B0); PG8_MMA(0, 1, At, B1); PG8_BAR; PG8_SCHED;
            PG8_LDA(At, 1, 1); PG8_STAGE(PG8_SB(1, 0), b3, voffB); PG8_STAGE(PG8_SB(1, 1), b3 + hstepB, voffB); PG8_STAGE(PG8_SA(1, 0), a3, voffA);
            PG8_WAIT_V(8); PG8_WAIT_L(0); PG8_BAR; PG8_MMA(1, 0, At, B0); PG8_MMA(1, 1, At, B1); PG8_BAR; PG8_SCHED;
        }
        if (wr == 0) PG8_BAR;
        E(acc, cur, wr, wc, fr, fq); S.done(cur);
        if (!has_next) break;
#pragma unroll
        for (int a = 0; a < 2; ++a)
#pragma unroll
            for (int b = 0; b < 2; ++b)
#pragma unroll
                for (int m = 0; m < 4; ++m)
#pragma unroll
                    for (int n = 0; n < 2; ++n) acc[a][b][m][n] = (f32x4){0.f, 0.f, 0.f, 0.f};
        cur = nxt; cA = nA; cB = nB; ++ui;
        if (wr == 1) PG8_BAR;
    }
    PG8_WAIT_V(0);
    PG8_BAR;
#undef PG8_SA
#undef PG8_SB
#undef PG8_STAGE
#undef PG8_LDA
#undef PG8_LDB
#undef PG8_MMA
#undef PG8_WAIT_V
#undef PG8_WAIT_L
#undef PG8_BAR
#undef PG8_SCHED
}
}

constexpr int NWAVES = 8;
constexpr int BATCH = 4, SEQ = 2048, D = 4096, M = BATCH * SEQ;
constexpr int HD = 128, NH = 16, NKV = 4, ATTW = 2048, KVW = 512, POOLW = 2048, PGW = 512, INW = 5120, FF = 11008;
constexpr float RMS_EPS = 1e-6f;
constexpr int N_PHASES = 12;

constexpr size_t MiB = 1u << 20;
constexpr size_t WS_CTL = 0, CTL_ZERO_BYTES = 1 * MiB;
constexpr size_t WS_COS = 1 * MiB, WS_SIN = WS_COS + 512 * 1024;
constexpr size_t WS_WGU1 = 2 * MiB;
constexpr size_t WS_WD1 = WS_WGU1 + 172 * MiB;
constexpr size_t WS_WIN = WS_WD1 + 86 * MiB;
constexpr size_t WS_WOUT = WS_WIN + 40 * MiB;
constexpr size_t WS_WPOOL = WS_WOUT + 32 * MiB;
constexpr size_t WS_WGU2 = WS_WPOOL + 2 * MiB;
constexpr size_t WS_WD2 = WS_WGU2 + 172 * MiB;
constexpr size_t WS_XN = WS_WD2 + 86 * MiB;
constexpr size_t WS_ACT = WS_XN + 64 * MiB;
constexpr size_t WS_HF = WS_ACT + 172 * MiB;
constexpr size_t WS_PROJ = WS_HF + 128 * MiB;
constexpr size_t WS_MIX = WS_PROJ + 80 * MiB;
constexpr size_t WS_YP = WS_MIX + 64 * MiB;
constexpr size_t WS_END = WS_YP + 32 * MiB;
static_assert((size_t)2 * FF * D * 2 == 172 * MiB && (size_t)D * FF * 2 == 86 * MiB && (size_t)M * FF * 2 == 172 * MiB, "sizes");
constexpr int CW_BAR = 4096;

constexpr int RING_OFF = 0, RING_BYTES = 131072;
constexpr int LDSCTL_OFF = RING_BYTES, MISC_OFF = LDSCTL_OFF + 320;
constexpr int LDS_BYTES = 147456;
constexpr int GAIN_OFF = 98304;
static_assert(MISC_OFF + 128 <= LDS_BYTES, "LDS map");

#define GAS __attribute__((address_space(1)))
#define LAS __attribute__((address_space(3)))
typedef unsigned short bf16;
typedef unsigned v4u __attribute__((ext_vector_type(4)));
typedef unsigned v2u __attribute__((ext_vector_type(2)));
typedef float f32x4 __attribute__((ext_vector_type(4)));
typedef float f32x16 __attribute__((ext_vector_type(16)));
typedef short bf16x8 __attribute__((ext_vector_type(8)));
typedef GAS unsigned gu32;
#define RLX_AGENT __ATOMIC_RELAXED, __HIP_MEMORY_SCOPE_AGENT
#define LDS_WAIT() asm volatile("s_waitcnt lgkmcnt(0)" ::: "memory")
#define VM_WAIT() asm volatile("s_waitcnt vmcnt(0)" ::: "memory")
__device__ __forceinline__ unsigned f2bf(float f) { unsigned u = __builtin_bit_cast(unsigned, f); return (u + 0x7fffu + ((u >> 16) & 1u)) >> 16; }
__device__ __forceinline__ unsigned pk2(float lo, float hi) { return f2bf(lo) | (f2bf(hi) << 16); }
__device__ __forceinline__ float bf_lo(unsigned w) { return __builtin_bit_cast(float, w << 16); }
__device__ __forceinline__ float bf_hi(unsigned w) { return __builtin_bit_cast(float, w & 0xffff0000u); }

#define XB_TMO      128
#define XB_XCNT(j)  (256  + 64 * (j))
#define XB_XSUB(j)  (1280 + 64 * (j))
#define XB_XGEN(j)  (2304 + 64 * (j))
#define XB_TOP      3328
#define XB_TOPGEN   3392
#define XCD_BAR_WORDS 3456
#define XB_SPIN_CAP (1u << 18)

__device__ __forceinline__ unsigned xb_ld(unsigned* p)              { return __hip_atomic_load(p, __ATOMIC_RELAXED, __HIP_MEMORY_SCOPE_AGENT); }
__device__ __forceinline__ unsigned xb_add(unsigned* p, unsigned v) { return __hip_atomic_fetch_add(p, v, __ATOMIC_RELAXED, __HIP_MEMORY_SCOPE_AGENT); }
__device__ __forceinline__ unsigned xb_xcc_id() { return (unsigned)__builtin_amdgcn_s_getreg((3 << 11) | 20) & 0xFu; }
#define XB_SPIN(cond, bar) do { unsigned _sp = 0; while (cond) { __builtin_amdgcn_s_sleep(1); \
    if ((++_sp & 255u) == 0u) { if (xb_ld(&(bar)[XB_TMO])) break; if (_sp > XB_SPIN_CAP) { atomicAdd(&(bar)[XB_TMO], 1u); break; } } } } while (0)

struct XcdBarrier {
    unsigned* bar; unsigned x;
    volatile LAS unsigned* st;
};
__device__ __forceinline__ XcdBarrier xcd_barrier_post(unsigned* bar, volatile LAS unsigned* st) {
    XcdBarrier b; b.bar = bar; b.x = xb_xcc_id(); b.st = st;
    if (threadIdx.x == 0) (void)xb_add(&bar[XB_XCNT(b.x)], 1u);
    return b;
}
__device__ __forceinline__ void xcd_barrier_complete(unsigned* bar, unsigned x, unsigned& nloc, unsigned& nx) {
    const unsigned G = gridDim.x * gridDim.y * gridDim.z;
    unsigned sum, cnt, mine, sp = 0u;
    for (;;) {
        sum = 0u; cnt = 0u; mine = 0u;
#pragma unroll
        for (unsigned j = 0; j < 16; ++j) { const unsigned c = xb_ld(&bar[XB_XCNT(j)]); sum += c; cnt += (c > 0u) ? 1u : 0u; mine = (j == x) ? c : mine; }
        if (sum == G) break;
        __builtin_amdgcn_s_sleep(1);
        if ((++sp & 255u) == 0u) { if (xb_ld(&bar[XB_TMO])) break; if (sp > XB_SPIN_CAP) { atomicAdd(&bar[XB_TMO], 1u); break; } }
    }
    nloc = mine > 0u ? mine : 1u; nx = cnt > 0u ? cnt : 1u;
}
__device__ __forceinline__ void xcd_barrier(const XcdBarrier& b) {
    asm volatile("s_waitcnt vmcnt(0)" ::: "memory");
    __syncthreads();
    if (threadIdx.x == 0) {
        unsigned* bar = b.bar;
        __builtin_amdgcn_s_waitcnt(0);
        unsigned nloc = b.st[0], nx = b.st[1];
        if (nloc == 0u) { xcd_barrier_complete(bar, b.x, nloc, nx); b.st[0] = nloc; b.st[1] = nx; }
        const unsigned old = xb_add(&bar[XB_XSUB(b.x)], 1u);
        const unsigned gen = old / nloc;
        if (old + 1u == (gen + 1u) * nloc) {
            __builtin_amdgcn_fence(__ATOMIC_RELEASE, "agent");
            asm volatile("s_waitcnt vmcnt(0)" ::: "memory");
            const unsigned og = xb_add(&bar[XB_TOP], 1u);
            const unsigned tg = og / nx;
            if (og + 1u == (tg + 1u) * nx) xb_add(&bar[XB_TOPGEN], 1u);
            else XB_SPIN(xb_ld(&bar[XB_TOPGEN]) == tg, bar);
            __builtin_amdgcn_fence(__ATOMIC_ACQUIRE, "agent");
            xb_add(&bar[XB_XGEN(b.x)], 1u);
            asm volatile("s_waitcnt vmcnt(0)" ::: "memory");
        } else {
            XB_SPIN(xb_ld(&bar[XB_XGEN(b.x)]) == gen, bar);
            __builtin_amdgcn_fence(__ATOMIC_ACQUIRE, "agent");
            asm volatile("s_waitcnt vmcnt(0)" ::: "memory");
        }
    }
    __syncthreads();
}

__device__ __forceinline__ int lane_id_v() { int l; asm volatile("v_mbcnt_lo_u32_b32 %0, -1, 0\n\tv_mbcnt_hi_u32_b32 %0, -1, %0" : "=v"(l)); return l; }
__device__ __forceinline__ float wave_sum(float v) {
#pragma unroll
    for (int o = 1; o < 64; o <<= 1) v += __shfl_xor(v, o);
    return v;
}
__device__ __forceinline__ void cvt_item(const float* W, int N, int k0, int n0, bf16* WT, int ldk, int drow0, LAS float* scr, int lane) {
    float v[32];
    const GAS float* src = (const GAS float*)W + (size_t)(k0 + (lane >> 5)) * N + n0 + (lane & 31);
#pragma unroll
    for (int i = 0; i < 32; ++i) v[i] = __builtin_nontemporal_load(src + (size_t)(2 * i) * N);
#pragma unroll
    for (int i = 0; i < 32; ++i) scr[(2 * i + (lane >> 5)) * 33 + (lane & 31)] = v[i];
    LDS_WAIT(); asm volatile("" ::: "memory");
    const int c = lane & 7;
#pragma unroll
    for (int j = 0; j < 4; ++j) { const int n = (lane >> 3) + 8 * j; const LAS float* s = scr + (8 * c) * 33 + n;
        v4u o; o.x = pk2(s[0 * 33], s[1 * 33]); o.y = pk2(s[2 * 33], s[3 * 33]); o.z = pk2(s[4 * 33], s[5 * 33]); o.w = pk2(s[6 * 33], s[7 * 33]);
        *(GAS v4u*)(WT + (size_t)(drow0 + n) * ldk + k0 + 8 * c) = o; }
    LDS_WAIT(); asm volatile("" ::: "memory");
}
__device__ __forceinline__ int drow_gu(int n0, int up) { return 256 * (n0 >> 7) + 128 * up + (n0 & 127); }
__device__ __forceinline__ int drow_in(int n0) { if (n0 >= 2560) return n0; const int pn = n0 >> 8, rem = n0 & 255, hsel = rem >> 7, r2 = rem & 127, bj = r2 >> 6, ii = r2 & 63; return 256 * pn + 128 * bj + 64 * hsel + ii; }

template <bool HAS_H, bool XIN_BF16, int WRITE_X  , bool WRITE_XN>
__device__ __forceinline__ void norm_row(const bf16* hrow, const void* xrow, void* xout, bf16* xn, float w, const LAS float* gpost, const LAS float* gpre, int lane) {
    asm volatile("" ::: "memory");
    f32x4 xv[16];
    if (XIN_BF16) { const GAS v2u* xr = (const GAS v2u*)xrow + lane;
#pragma unroll
        for (int j = 0; j < 16; ++j) { const v2u q = xr[64 * j]; xv[j] = (f32x4){bf_lo(q.x), bf_hi(q.x), bf_lo(q.y), bf_hi(q.y)}; }
    } else { const GAS f32x4* xr = (const GAS f32x4*)xrow + lane;
#pragma unroll
        for (int j = 0; j < 16; ++j) xv[j] = xr[64 * j]; }
    if (HAS_H) {
        f32x4 hv[16]; const GAS v2u* hr = (const GAS v2u*)hrow + lane; float s = 0.f;
#pragma unroll
        for (int j = 0; j < 16; ++j) { const v2u q = hr[64 * j]; hv[j] = (f32x4){bf_lo(q.x), bf_hi(q.x), bf_lo(q.y), bf_hi(q.y)}; }
#pragma unroll
        for (int j = 0; j < 16; ++j) s += (hv[j].x * hv[j].x + hv[j].y * hv[j].y) + (hv[j].z * hv[j].z + hv[j].w * hv[j].w);
        const float rstd = w / sqrtf(wave_sum(s) * (1.f / D) + RMS_EPS);
#pragma unroll
        for (int j = 0; j < 16; ++j) { const f32x4 gg = *(const LAS f32x4*)(gpost + 4 * lane + 256 * j); xv[j] = xv[j] + hv[j] * rstd * gg; }
        if (WRITE_X == 1) { GAS f32x4* xo = (GAS f32x4*)xout + lane;
#pragma unroll
            for (int j = 0; j < 16; ++j) xo[64 * j] = xv[j]; }
        if (WRITE_X == 2) { GAS v2u* xo = (GAS v2u*)xout + lane;
#pragma unroll
            for (int j = 0; j < 16; ++j) { v2u pk; pk.x = pk2(xv[j].x, xv[j].y); pk.y = pk2(xv[j].z, xv[j].w); xo[64 * j] = pk; } }
    }
    if (WRITE_XN) {
        float s2 = 0.f;
#pragma unroll
        for (int j = 0; j < 16; ++j) s2 += (xv[j].x * xv[j].x + xv[j].y * xv[j].y) + (xv[j].z * xv[j].z + xv[j].w * xv[j].w);
        const float rstd2 = 1.f / sqrtf(wave_sum(s2) * (1.f / D) + RMS_EPS);
        GAS v2u* o8 = (GAS v2u*)xn + lane;
#pragma unroll
        for (int j = 0; j < 16; ++j) { const f32x4 gg = *(const LAS f32x4*)(gpre + 4 * lane + 256 * j); const f32x4 o = xv[j] * rstd2 * gg;
            v2u pk; pk.x = pk2(o.x, o.y); pk.y = pk2(o.z, o.w); o8[64 * j] = pk; }
    }
}

template <int W, bool FIRST>
__device__ __forceinline__ void pool_item(const bf16* proj, bf16* yp, int g, int row0, int lane) {
#pragma unroll
    for (int sub = 0; sub < 2; ++sub) {
        v4u r[W + 7];
        const GAS v4u* src = (const GAS v4u*)(proj + (size_t)(row0 + 8 * sub) * INW + (ATTW + 2 * KVW) + PGW * g + 8 * lane);
#pragma unroll
        for (int i = 0; i < W + 7; ++i) { const int d = i - (W - 1); if (FIRST && 8 * sub + d < 0) r[i] = (v4u){0u, 0u, 0u, 0u}; else r[i] = src[(long)d * (INW / 8)]; }
        GAS v4u* dst = (GAS v4u*)(yp + (size_t)(row0 + 8 * sub) * POOLW + PGW * g + 8 * lane);
#pragma unroll
        for (int k = 0; k < 8; ++k) {
            float a[8] = {0.f, 0.f, 0.f, 0.f, 0.f, 0.f, 0.f, 0.f};
#pragma unroll
            for (int j = 0; j < W; ++j) { if (FIRST && 8 * sub + k + j < W - 1) continue; const v4u q = r[k + j]; a[0] += bf_lo(q.x); a[1] += bf_hi(q.x); a[2] += bf_lo(q.y); a[3] += bf_hi(q.y); a[4] += bf_lo(q.z); a[5] += bf_hi(q.z); a[6] += bf_lo(q.w); a[7] += bf_hi(q.w); }
            const int cnt = (FIRST && 8 * sub + k + 1 < W) ? (8 * sub + k + 1) : W; const float ic = 1.0f / (float)cnt; const v4u p = r[k + W - 1];
            v4u o; o.x = pk2(a[0] * ic - bf_lo(p.x), a[1] * ic - bf_hi(p.x)); o.y = pk2(a[2] * ic - bf_lo(p.y), a[3] * ic - bf_hi(p.y));
            o.z = pk2(a[4] * ic - bf_lo(p.z), a[5] * ic - bf_hi(p.z)); o.w = pk2(a[6] * ic - bf_lo(p.w), a[7] * ic - bf_hi(p.w));
            dst[(size_t)k * (POOLW / 8)] = o;
        }
        asm volatile("" ::: "memory");
    }
}
template <int W>
__device__ __forceinline__ void pool_item2(const bf16* proj, bf16* yp, int g, int row0, int lane) {
    if ((row0 & (SEQ - 1)) == 0) pool_item<W, true>(proj, yp, g, row0, lane); else pool_item<W, false>(proj, yp, g, row0, lane);
}

constexpr int AT_KROWS = 192, AT_KSTR = 272, AT_VSTR = 392, AT_K_OFF = 0, AT_VT_OFF = AT_KROWS * AT_KSTR;
static_assert(AT_VT_OFF + 128 * AT_VSTR <= RING_BYTES, "attention LDS");
__device__ __forceinline__ void attn_unit(LAS unsigned char* lds, const bf16* proj, bf16* mix, const float* sinks, int unit, int tid, int wid) {
    asm volatile("" : "+v"(tid));
    const int lane = tid & 63;
    const int b = unit >> 7, kvh = (unit >> 5) & 3, qb = unit & 31, q0 = qb * 64, rowbase = b * SEQ;
#pragma unroll
    for (int i = 0; i < 6; ++i) { const int c = tid + 512 * i, key = c >> 4, ch = c & 15; int kp = q0 - 128 + key; kp = kp < 0 ? 0 : kp;
        const v4u v = *(const GAS v4u*)(proj + (size_t)(rowbase + kp) * INW + ATTW + kvh * HD + ch * 8);
        *(LAS v4u*)(lds + AT_K_OFF + key * AT_KSTR + ch * 16) = v; }
#pragma unroll
    for (int i = 0; i < 6; ++i) { const int c = tid + 512 * i, ch = c / 192, key = c - ch * 192; int kp = q0 - 128 + key; kp = kp < 0 ? 0 : kp;
        const v4u v = *(const GAS v4u*)(proj + (size_t)(rowbase + kp) * INW + ATTW + KVW + kvh * HD + ch * 8);
        LAS unsigned short* d = (LAS unsigned short*)(lds + AT_VT_OFF + (ch * 8) * AT_VSTR + key * 2);
        d[0 * (AT_VSTR / 2)] = (unsigned short)(v.x & 0xffffu); d[1 * (AT_VSTR / 2)] = (unsigned short)(v.x >> 16);
        d[2 * (AT_VSTR / 2)] = (unsigned short)(v.y & 0xffffu); d[3 * (AT_VSTR / 2)] = (unsigned short)(v.y >> 16);
        d[4 * (AT_VSTR / 2)] = (unsigned short)(v.z & 0xffffu); d[5 * (AT_VSTR / 2)] = (unsigned short)(v.z >> 16);
        d[6 * (AT_VSTR / 2)] = (unsigned short)(v.w & 0xffffu); d[7 * (AT_VSTR / 2)] = (unsigned short)(v.w >> 16); }
    __syncthreads();
    const int hq = kvh * 4 + (wid >> 1), s = wid & 1, ql = lane & 31, h = lane >> 5;
    const int qrow = rowbase + q0 + 32 * s + ql;
    bf16x8 qf[8];
#pragma unroll
    for (int kk = 0; kk < 8; ++kk) qf[kk] = *(const GAS bf16x8*)(proj + (size_t)qrow * INW + hq * HD + 16 * kk + 8 * h);
    f32x16 sc[5];
#pragma unroll
    for (int kt = 0; kt < 5; ++kt) {
        f32x16 a; for (int r = 0; r < 16; ++r) a[r] = 0.f;
#pragma unroll
        for (int kk = 0; kk < 8; ++kk) { const bf16x8 kf = *(const LAS bf16x8*)(lds + AT_K_OFF + (32 * (s + kt) + ql) * AT_KSTR + (16 * kk + 8 * h) * 2);
            a = __builtin_amdgcn_mfma_f32_32x32x16_bf16(kf, qf[kk], a, 0, 0, 0); }
        sc[kt] = a;
    }
    const float sc2 = 0.08838834764831845f * 1.4426950408889634f;
    const float sink2 = sinks[hq] * 1.4426950408889634f;
    float mx = -__builtin_inff();
    const int tmin = 4 - 2 * qb;
#pragma unroll
    for (int kt = 0; kt < 5; ++kt) {
        const bool tile_ok = (s + kt) >= tmin;
#pragma unroll
        for (int r = 0; r < 16; ++r) { const int koff = (r & 3) + 8 * (r >> 2) + 4 * h;
            bool valid = tile_ok; if (kt == 0) valid = valid && (koff > ql); if (kt == 4) valid = valid && (koff <= ql);
            const float v = valid ? sc[kt][r] * sc2 : -__builtin_inff(); sc[kt][r] = v; mx = fmaxf(mx, v); }
    }
    mx = fmaxf(mx, __shfl_xor(mx, 32)); mx = fmaxf(mx, sink2);
    float sum = 0.f;
#pragma unroll
    for (int kt = 0; kt < 5; ++kt)
#pragma unroll
        for (int r = 0; r < 16; ++r) { const float e = __builtin_amdgcn_exp2f(sc[kt][r] - mx); sc[kt][r] = e; sum += e; }
    sum += __shfl_xor(sum, 32);
    const float inv = 1.0f / (sum + __builtin_amdgcn_exp2f(sink2 - mx));
    f32x16 oacc[4];
#pragma unroll
    for (int dt = 0; dt < 4; ++dt) for (int r = 0; r < 16; ++r) oacc[dt][r] = 0.f;
#pragma unroll
    for (int kt = 0; kt < 5; ++kt)
#pragma unroll
        for (int s2 = 0; s2 < 2; ++s2) {
            v4u pw; pw.x = pg8::cvt_pk_bf16(sc[kt][8 * s2 + 0], sc[kt][8 * s2 + 1]); pw.y = pg8::cvt_pk_bf16(sc[kt][8 * s2 + 2], sc[kt][8 * s2 + 3]);
            pw.z = pg8::cvt_pk_bf16(sc[kt][8 * s2 + 4], sc[kt][8 * s2 + 5]); pw.w = pg8::cvt_pk_bf16(sc[kt][8 * s2 + 6], sc[kt][8 * s2 + 7]);
            const bf16x8 pf = __builtin_bit_cast(bf16x8, pw);
#pragma unroll
            for (int dt = 0; dt < 4; ++dt) { const LAS unsigned char* vb = lds + AT_VT_OFF + (32 * dt + ql) * AT_VSTR + (32 * (s + kt) + 16 * s2 + 4 * h) * 2;
                const v2u lo = *(const LAS v2u*)vb, hi = *(const LAS v2u*)(vb + 16);
                v4u vw; vw.x = lo.x; vw.y = lo.y; vw.z = hi.x; vw.w = hi.y;
                oacc[dt] = __builtin_amdgcn_mfma_f32_32x32x16_bf16(__builtin_bit_cast(bf16x8, vw), pf, oacc[dt], 0, 0, 0); }
        }
    bf16* orow = mix + (size_t)qrow * D + hq * HD;
#pragma unroll
    for (int dt = 0; dt < 4; ++dt)
#pragma unroll
        for (int g4 = 0; g4 < 4; ++g4) { v2u o; o.x = pg8::cvt_pk_bf16(oacc[dt][4 * g4 + 0] * inv, oacc[dt][4 * g4 + 1] * inv); o.y = pg8::cvt_pk_bf16(oacc[dt][4 * g4 + 2] * inv, oacc[dt][4 * g4 + 3] * inv);
            *(GAS v2u*)(orow + 32 * dt + 8 * g4 + 4 * h) = o; }
    __syncthreads();
}

__device__ const double INV_FREQ[64] = {
    1.0, 0.8659643233600653, 0.7498942093324559, 0.6493816315762113, 0.5623413251903491, 0.4869675251658631, 0.4216965034285822, 0.3651741272548377, 0.31622776601683794, 0.27384196342643613, 0.23713737056616552, 0.2053525026457146, 0.1778279410038923, 0.1539926526059492, 0.1333521432163324, 0.11547819846894582,
    0.1, 0.08659643233600653, 0.07498942093324558, 0.06493816315762113, 0.05623413251903491, 0.04869675251658631, 0.042169650342858224, 0.03651741272548377, 0.03162277660168379, 0.027384196342643614, 0.023713737056616554, 0.02053525026457146, 0.01778279410038923, 0.01539926526059492, 0.01333521432163324, 0.011547819846894581,
    0.01, 0.008659643233600654, 0.007498942093324558, 0.006493816315762113, 0.005623413251903491, 0.004869675251658631, 0.004216965034285823, 0.003651741272548377, 0.0031622776601683794, 0.0027384196342643613, 0.0023713737056616554, 0.002053525026457146, 0.0017782794100389228, 0.001539926526059492, 0.001333521432163324, 0.0011547819846894581,
    0.001, 0.0008659643233600654, 0.0007498942093324559, 0.0006493816315762113, 0.0005623413251903491, 0.0004869675251658631, 0.00042169650342858224, 0.0003651741272548377, 0.00031622776601683794, 0.0002738419634264361, 0.00023713737056616554, 0.0002053525026457146, 0.00017782794100389227, 0.0001539926526059492, 0.0001333521432163324, 0.00011547819846894582};
__device__ __forceinline__ void sincos_d(double a, double& sn, double& cs) {
    const double k = __builtin_rint(a * 0.6366197723675814);
    double r = __builtin_fma(-k, 1.5707963267948966, a); r = __builtin_fma(-k, 6.123233995736766e-17, r);
    const double r2 = r * r;
    double sp = -7.647163731819816e-13; sp = sp * r2 + 1.6059043836821613e-10; sp = sp * r2 - 2.505210838544172e-08; sp = sp * r2 + 2.7557319223985893e-06; sp = sp * r2 - 0.0001984126984126984; sp = sp * r2 + 0.008333333333333333; sp = sp * r2 - 0.16666666666666666; sp = r + r * r2 * sp;
    double cp = 4.779477332387385e-14; cp = cp * r2 - 1.1470745597729725e-11; cp = cp * r2 + 2.08767569878681e-09; cp = cp * r2 - 2.755731922398589e-07; cp = cp * r2 + 2.48015873015873e-05; cp = cp * r2 - 0.001388888888888889; cp = cp * r2 + 0.041666666666666664; cp = cp * r2 - 0.5; cp = 1.0 + r2 * cp;
    const int q = ((int)k) & 3;
    sn = (q == 0) ? sp : (q == 1) ? cp : (q == 2) ? -sp : -cp;
    cs = (q == 0) ? cp : (q == 1) ? -sp : (q == 2) ? -cp : sp;
}

struct Args { const float* in[18]; float* out; unsigned char* ws; int ph_lo, ph_hi; };
static_assert(sizeof(Args) == 18 * 8 + 8 + 8 + 8, "Args has no padding");

constexpr int I_G = (D / 64) * (FF / 32), I_D = (FF / 64) * (D / 32), I_IN = (D / 64) * (INW / 32), I_OUT = (D / 64) * (D / 32), I_P = (PGW / 64) * (PGW / 32);
static_assert(I_D == I_G, "items");
constexpr int CV_R0 = 2 * I_G, CV_R1 = CV_R0 + I_D + I_IN, CV_R2 = CV_R1 + I_OUT + 4 * I_P + 2 * I_G, CV_R3 = CV_R2 + I_D;
__device__ __forceinline__ void cvt_any(const Args& args, int it, LAS float* scr, int lane) {
    int r = it, idx, N, ldk, kind = 0, nshift = 0; size_t dst; size_t soff = 0;
    if (r < CV_R0) { const int up = r >= I_G; r -= up * I_G; idx = 2 + up; N = FF; ldk = D; dst = WS_WGU1; kind = 1 + up; }
    else if ((r -= CV_R0) < I_D) { idx = 4; N = D; ldk = FF; dst = WS_WD1; }
    else if ((r -= I_D) < I_IN) { idx = 7; N = INW; ldk = D; dst = WS_WIN; kind = 3; }
    else if ((r -= I_IN) < I_OUT) { idx = 11; N = D; ldk = D; dst = WS_WOUT; }
    else if ((r -= I_OUT) < 4 * I_P) { const int gq = r / I_P; r -= gq * I_P; idx = 9; N = PGW; ldk = PGW; dst = WS_WPOOL; soff = (size_t)gq * PGW * PGW; nshift = PGW * gq; }
    else if ((r -= 4 * I_P) < 2 * I_G) { const int up = r >= I_G; r -= up * I_G; idx = 14 + up; N = FF; ldk = D; dst = WS_WGU2; kind = 1 + up; }
    else { r -= 2 * I_G; idx = 16; N = D; ldk = FF; dst = WS_WD2; }
    const int nblk = N >> 5, kb = r / nblk, nb = r - kb * nblk, n0 = 32 * nb;
    const int drow = (kind == 0) ? (nshift + n0) : (kind == 3) ? drow_in(n0) : drow_gu(n0, kind - 1);
    cvt_item(args.in[idx] + soff, N, 64 * kb, n0, (bf16*)(args.ws + dst), ldk, drow, scr, lane);
}
constexpr int CW_TMO = 0, CW_PCNT = 8192, CW_ROWSUM = 32768;
static_assert((CW_ROWSUM + M) * 4 <= (int)CTL_ZERO_BYTES && CW_PCNT + 64 * 32 <= CW_ROWSUM, "control words");
constexpr int CW_Q1 = 1024, CW_Q2 = 1088, CW_Q3 = 1152;

__global__ void __launch_bounds__(NWAVES * 64, 2) hymba_fwd(Args args) {
    extern __shared__ __attribute__((aligned(16))) unsigned char lds_raw[];
    LAS unsigned char* lds = (LAS unsigned char*)lds_raw;
    volatile LAS unsigned* MISC = (volatile LAS unsigned*)(lds + MISC_OFF);
    const int wave = __builtin_amdgcn_readfirstlane((int)threadIdx.x >> 6);
#define PH_IDS const int lane = lane_id_v(), tid = wave * 64 + lane; (void)tid
    const int G = gridDim.x; const int bx = blockIdx.x; const int vcu = (G % 8 == 0) ? (bx % 8) * (G / 8) + bx / 8 : bx;
    const int gw = vcu * NWAVES + wave, NGW = G * NWAVES;
    gu32* ctl = (gu32*)(args.ws + WS_CTL);
#define WSP(T, off) ((T*)(args.ws + (off)))
#define WGU1 WSP(bf16, WS_WGU1)
#define WD1 WSP(bf16, WS_WD1)
#define WIN WSP(bf16, WS_WIN)
#define WOUT WSP(bf16, WS_WOUT)
#define WPOOL WSP(bf16, WS_WPOOL)
#define WGU2 WSP(bf16, WS_WGU2)
#define WD2 WSP(bf16, WS_WD2)
#define XN WSP(bf16, WS_XN)
#define ACT WSP(bf16, WS_ACT)
#define HF WSP(bf16, WS_HF)
#define XRES WSP(bf16, WS_HF + 64 * MiB)
#define PROJ WSP(bf16, WS_PROJ)
#define MIX WSP(bf16, WS_MIX)
#define YP WSP(bf16, WS_YP)
#define COS WSP(float, WS_COS)
#define SIN WSP(float, WS_SIN)
#define XIN (args.in[0])
#define OUTP (args.out)
    LAS float* gA = (LAS float*)(lds + GAIN_OFF); LAS float* gB = (LAS float*)(lds + GAIN_OFF + 16384);

    for (int u = threadIdx.x; u < (LDS_BYTES - LDSCTL_OFF) / 4; u += NWAVES * 64) ((LAS unsigned*)(lds + LDSCTL_OFF))[u] = 0u;
    __syncthreads();
    XcdBarrier bar; bar.bar = (unsigned*)(ctl + CW_BAR); bar.x = 0; bar.st = nullptr;
    if (!MK_SPLIT) bar = xcd_barrier_post((unsigned*)(ctl + CW_BAR), MISC + 8);
    const int lo = args.ph_lo, hi = args.ph_hi;
#ifndef REPMASK
#define REPMASK 0
#endif
#define NREP(k) (((REPMASK >> (k)) & 1) ? 2 : 1)
#ifndef PHMASK
#define PHMASK 0xfff
#endif
#define IN(k) (((PHMASK >> (k)) & 1) && lo <= (k) && (k) < hi)
#define SEAM(k) do { if (IN(k) && IN((k) + 1)) xcd_barrier(bar); } while (0)
#define LOAD_GAINS(pa, pb) do { for (int _u = tid; _u < D / 4; _u += NWAVES * 64) { ((LAS f32x4*)gA)[_u] = ((const GAS f32x4*)(pa))[_u]; ((LAS f32x4*)gB)[_u] = ((const GAS f32x4*)(pb))[_u]; } __syncthreads(); } while (0)

#define CVT_QUEUE(qword, lo_it, hi_it) do { LAS float* scr_ = (LAS float*)(lds + RING_OFF + wave * 8448); \
        for (;;) { if (tid == 0) MISC[0] = (unsigned)(lo_it) + __hip_atomic_fetch_add((unsigned*)(ctl + (qword)), 32u, __ATOMIC_RELAXED, __HIP_MEMORY_SCOPE_AGENT); \
            __syncthreads(); const int base_ = (int)MISC[0]; __syncthreads(); if (base_ >= (hi_it)) break; \
            _Pragma("unroll 1") for (int j_ = 0; j_ < 4; ++j_) { const int it_ = base_ + wave * 4 + j_; if (it_ < (hi_it)) cvt_any(args, it_, scr_, lane); } } } while (0)
    if (IN(0)) for (int rep_ = 0; rep_ < NREP(0); ++rep_) {
        PH_IDS;
        for (int i = gw * 64 + lane; i < SEQ * 64; i += NGW * 64) { const int pos = i >> 6, f = i & 63; double sn, cs; sincos_d((double)pos * INV_FREQ[f], sn, cs); WSP(float, WS_COS)[i] = (float)cs; WSP(float, WS_SIN)[i] = (float)sn; }
        LOAD_GAINS(args.in[1], args.in[1]);
#pragma unroll 1
        for (int m = gw; m < M; m += NGW) norm_row<false, false, 0, true>(nullptr, XIN + (size_t)m * D, nullptr, XN + (size_t)m * D, 0.f, gA, gB, lane);
        LAS float* scr = (LAS float*)(lds + RING_OFF + wave * 8448);
#pragma unroll 1
        for (int it = gw; it < CV_R0; it += NGW) cvt_any(args, it, scr, lane);
        __syncthreads();
    }
    SEAM(0);
    if (IN(1)) for (int rep_ = 0; rep_ < NREP(1); ++rep_) {
        PH_IDS;
        pg8::Gemm g{XN, WGU1, M, 2 * FF, D, D, D, 0, 0}; pg8::StaticOrder S; S.init(M, 2 * FF, G, bx);
        pg8::EpiSwiGLU E{ACT, FF};
        pg8::gemm_phase<pg8::EpiSwiGLU, pg8::StaticOrder>(lds + RING_OFF, g, S, E, wave, lane);
        if (rep_ == 0) CVT_QUEUE(CW_Q1, CV_R0, CV_R1);
    }
    SEAM(1);
    if (IN(2)) for (int rep_ = 0; rep_ < NREP(2); ++rep_) {
        PH_IDS;
        pg8::Gemm g{ACT, WD1, M, D, FF, FF, FF, 0, 0}; pg8::StaticOrder S; S.init(M, D, G, bx);
        pg8::EpiBf16 E{HF, D};
        pg8::gemm_phase<pg8::EpiBf16, pg8::StaticOrder>(lds + RING_OFF, g, S, E, wave, lane);
    }
    SEAM(2);
    if (IN(3)) for (int rep_ = 0; rep_ < NREP(3); ++rep_) {
        PH_IDS;
        LOAD_GAINS(args.in[5], args.in[6]);
#pragma unroll 1
        for (int m = gw; m < M; m += NGW) norm_row<true, false, 2, true>(HF + (size_t)m * D, XIN + (size_t)m * D, XRES + (size_t)m * D, XN + (size_t)m * D, 0.5f, gA, gB, lane);
        __syncthreads();
    }
    SEAM(3);
    if (IN(4)) for (int rep_ = 0; rep_ < NREP(4); ++rep_) {
        PH_IDS;
        pg8::Gemm g{XN, WIN, M, INW, D, D, D, 0, 0}; pg8::StaticOrder S; S.init(M, INW, G, bx);
        pg8::EpiInProj E{PROJ, INW, COS, SIN};
        pg8::gemm_phase<pg8::EpiInProj, pg8::StaticOrder>(lds + RING_OFF, g, S, E, wave, lane);
        if (rep_ == 0) CVT_QUEUE(CW_Q2, CV_R1, CV_R2);
    }
    SEAM(4);
    if (IN(5)) for (int rep_ = 0; rep_ < NREP(5); ++rep_) {
        PH_IDS;
#pragma unroll 1
        for (int it = gw; it < 4 * (M / 16); it += NGW) { const int gq = it & 3, row0 = (it >> 2) * 16;
            if (gq == 0) pool_item2<2>(PROJ, YP, 0, row0, lane); else if (gq == 1) pool_item2<4>(PROJ, YP, 1, row0, lane);
            else if (gq == 2) pool_item2<8>(PROJ, YP, 2, row0, lane); else pool_item2<16>(PROJ, YP, 3, row0, lane); }
#pragma unroll 1
        for (int un = vcu; un < BATCH * NKV * (SEQ / 64); un += G) attn_unit(lds + RING_OFF, PROJ, MIX, args.in[8], un, tid, wave);
    }
    SEAM(5);
    if (IN(6)) for (int rep_ = 0; rep_ < NREP(6); ++rep_) {
        PH_IDS;
        pg8::Gemm g{YP, WPOOL, M, POOLW, PGW, POOLW, PGW, 1, PGW}; pg8::StaticOrder S; S.init(M, POOLW, G, bx);
        pg8::EpiPool E{MIX + ATTW, D, args.in[10]};
        pg8::gemm_phase<pg8::EpiPool, pg8::StaticOrder>(lds + RING_OFF, g, S, E, wave, lane);
    }
    SEAM(6);
    if (IN(7)) for (int rep_ = 0; rep_ < NREP(7); ++rep_) {
        PH_IDS;
        pg8::Gemm g{MIX, WOUT, M, D, D, D, D, 0, 0}; pg8::StaticOrder S; S.init(M, D, G, bx);
        pg8::EpiBf16 E{HF, D};
        pg8::gemm_phase<pg8::EpiBf16, pg8::StaticOrder>(lds + RING_OFF, g, S, E, wave, lane);
    }
    SEAM(7);
    if (IN(8)) for (int rep_ = 0; rep_ < NREP(8); ++rep_) {
        PH_IDS;
        LOAD_GAINS(args.in[12], args.in[13]);
#pragma unroll 1
        for (int m = gw; m < M; m += NGW) norm_row<true, true, 2, true>(HF + (size_t)m * D, XRES + (size_t)m * D, XRES + (size_t)m * D, XN + (size_t)m * D, 1.0f, gA, gB, lane);
        __syncthreads();
    }
    SEAM(8);
    if (IN(9)) for (int rep_ = 0; rep_ < NREP(9); ++rep_) {
        PH_IDS;
        pg8::Gemm g{XN, WGU2, M, 2 * FF, D, D, D, 0, 0}; pg8::StaticOrder S; S.init(M, 2 * FF, G, bx);
        pg8::EpiSwiGLU E{ACT, FF};
        pg8::gemm_phase<pg8::EpiSwiGLU, pg8::StaticOrder>(lds + RING_OFF, g, S, E, wave, lane);
        if (rep_ == 0) CVT_QUEUE(CW_Q3, CV_R2, CV_R3);
    }
    SEAM(9);
    const bool fused_final = (G == 256);
    if (IN(10)) for (int rep_ = 0; rep_ < NREP(10); ++rep_) {
        PH_IDS;
        if (fused_final) {
            pg8::Gemm g{ACT, WD2, M, D, FF, FF, FF, 0, 0}; pg8::DownOrder S; S.init(M, D, G, bx);
            pg8::EpiFinalNorm E{XRES, args.in[17], OUTP, (float*)(ctl + CW_ROWSUM), (unsigned*)(ctl + CW_PCNT), (unsigned*)(ctl + CW_TMO), D, 0.5f, RMS_EPS};
            pg8::gemm_phase<pg8::EpiFinalNorm, pg8::DownOrder>(lds + RING_OFF, g, S, E, wave, lane);
        } else {
            pg8::Gemm g{ACT, WD2, M, D, FF, FF, FF, 0, 0}; pg8::StaticOrder S; S.init(M, D, G, bx);
            pg8::EpiBf16 E{HF, D};
            pg8::gemm_phase<pg8::EpiBf16, pg8::StaticOrder>(lds + RING_OFF, g, S, E, wave, lane);
        }
    }
    if (!fused_final) SEAM(10);
    if (IN(11) && !fused_final) for (int rep_ = 0; rep_ < NREP(11); ++rep_) {
        PH_IDS;
        LOAD_GAINS(args.in[17], args.in[17]);
#pragma unroll 1
        for (int m = gw; m < M; m += NGW) norm_row<true, true, 1, false>(HF + (size_t)m * D, XRES + (size_t)m * D, OUTP + (size_t)m * D, nullptr, 0.5f, gA, gB, lane);
    }
#undef IN
#undef SEAM
#undef LOAD_GAINS
#undef CVT_QUEUE
#undef PH_IDS
}

extern "C" void kernel_launch(void* const* d_in, const int* in_sizes, int n_in, void* d_out, int out_size, void* d_ws, size_t ws_size, hipStream_t stream) {
    static int grid = 0;
    if (grid == 0) {
        if (n_in != 18 || in_sizes[0] != M * D || out_size != M * D || ws_size < WS_END) { fprintf(stderr, "kernel_launch: unexpected shapes (n_in %d, in0 %d, out %d, ws %zu, need %zu); nothing launched\n", n_in, n_in > 0 ? in_sizes[0] : -1, out_size, ws_size, (size_t)WS_END); grid = -1; return; }
        int dev = 0, cus = 0, per_cu = 0;
        if (hipGetDevice(&dev) != hipSuccess || hipDeviceGetAttribute(&cus, hipDeviceAttributeMultiprocessorCount, dev) != hipSuccess) { fprintf(stderr, "kernel_launch: device query failed\n"); grid = -1; return; }
        if (hipFuncSetAttribute((const void*)hymba_fwd, hipFuncAttributeMaxDynamicSharedMemorySize, LDS_BYTES) != hipSuccess) { fprintf(stderr, "kernel_launch: hipFuncSetAttribute failed\n"); grid = -1; return; }
        if (hipOccupancyMaxActiveBlocksPerMultiprocessor(&per_cu, (const void*)hymba_fwd, NWAVES * 64, LDS_BYTES) != hipSuccess || per_cu < 1)
            fprintf(stderr, "kernel_launch: note: occupancy query reports %d workgroups per CU\n", per_cu);
        (void)hipGetLastError();
        grid = cus;
    }
    if (grid < 0) return;
    if (hipMemsetAsync((char*)d_ws + WS_CTL, 0, CTL_ZERO_BYTES, stream) != hipSuccess) { fprintf(stderr, "kernel_launch: memset failed\n"); return; }
    Args a{};
    for (int i = 0; i < 18; ++i) a.in[i] = (const float*)d_in[i];
    a.out = (float*)d_out; a.ws = (unsigned char*)d_ws;
#if MK_SPLIT
    for (int p = 0; p < N_PHASES; ++p) { a.ph_lo = p; a.ph_hi = p + 1; hipLaunchKernelGGL(hymba_fwd, dim3(grid), dim3(NWAVES * 64), LDS_BYTES, stream, a); }
#else
    a.ph_lo = 0; a.ph_hi = N_PHASES;
    hipLaunchKernelGGL(hymba_fwd, dim3(grid), dim3(NWAVES * 64), LDS_BYTES, stream, a);
#endif
    const hipError_t le = hipPeekAtLastError();
    if (le != hipSuccess) fprintf(stderr, "kernel_launch: launch failed: %s\n", hipGetErrorName(le));
}
```

```cpp
#include <hip/hip_runtime.h>
#include <cstdio>
#include <cstdint>

#ifndef MK_SPLIT
#define MK_SPLIT 0
#endif

namespace pg8 {
#define PG8_LAS __attribute__((address_space(3)))
typedef unsigned short bf16_t;
typedef short bf16x8 __attribute__((ext_vector_type(8)));
typedef float f32x4 __attribute__((ext_vector_type(4)));
typedef unsigned u32x4 __attribute__((ext_vector_type(4)));
typedef int i32x8 __attribute__((ext_vector_type(8)));
constexpr int BM = 256, BK = 64, HALF = 128, HTB = HALF * BK * 2  , STAGE_BYTES = 8 * HTB, NXCD = 8, WGM = 8;

__host__ __device__ __forceinline__ int lds_byte(int r, int c) { return r * 128 + ((((c >> 3) ^ (r >> 1)) & 7) << 4) + (c & 7) * 2; }
__host__ __device__ __forceinline__ void stage_rc(int b, int& R, int& C) { R = b >> 7; C = ((((b >> 4) ^ (R >> 1)) & 7) << 3) + ((b & 15) >> 1); }
__host__ __device__ __forceinline__ int perm32(int rho) { const int n = rho >> 4, i = rho & 15; return 8 * (i >> 2) + 4 * n + (i & 3); }

struct Unit { int pm, pn; };
struct Gemm { const bf16_t* A; const bf16_t* Bt; int M, N, K, lda, ldb, a_shift, a_step; };

struct StaticOrder {
    int nM, nN, nwg, G, c;
    __host__ __device__ void init(int M, int N, int G_, int c_) { nM = M / BM; nN = N / BM; nwg = nM * nN; G = G_; c = c_; }
    __host__ __device__ bool next(int i, Unit& u) const {
        const long L = (long)i * G + c; if (L >= nwg) return false;
        int wgid = (int)L; { const int q = nwg / NXCD, r = nwg % NXCD, xcd = wgid % NXCD, off = wgid / NXCD; wgid = (xcd < r ? xcd * (q + 1) : r * (q + 1) + (xcd - r) * q) + off; }
        const int nig = WGM * nN, gid = wgid / nig, fm = gid * WGM, gsz = (nM - fm) < WGM ? (nM - fm) : WGM;
        u.pm = fm + ((wgid % nig) % gsz); u.pn = (wgid % nig) / gsz; return true;
    }
    __device__ __forceinline__ void a_ready(const Unit&) const {}
    __device__ __forceinline__ void done(const Unit&) const {}
};

__device__ __forceinline__ unsigned cvt_pk_bf16(float lo, float hi) { unsigned r; asm volatile("v_cvt_pk_bf16_f32 %0, %1, %2" : "=v"(r) : "v"(lo), "v"(hi)); return r; }
__device__ __forceinline__ u32x4 pack8(const f32x4 a, const f32x4 b) { u32x4 w; w.x = cvt_pk_bf16(a[0], a[1]); w.y = cvt_pk_bf16(a[2], a[3]); w.z = cvt_pk_bf16(b[0], b[1]); w.w = cvt_pk_bf16(b[2], b[3]); return w; }

struct EpiF32 {
    static constexpr bool PERM = false;
    float* C; int ldc;
    __device__ __forceinline__ void operator()(const f32x4 (&acc)[2][2][4][2], const Unit& u, int wr, int wc, int fr, int fq) const {
        const int row0 = u.pm * BM + wr * 64 + fr, col0 = u.pn * BM + wc * 32 + 4 * fq;
#pragma unroll
        for (int ai = 0; ai < 2; ++ai)
#pragma unroll
            for (int m = 0; m < 4; ++m) { float* rowp = C + (size_t)(row0 + ai * HALF + m * 16) * ldc + col0;
#pragma unroll
                for (int bj = 0; bj < 2; ++bj)
#pragma unroll
                    for (int n = 0; n < 2; ++n) *(f32x4*)(rowp + bj * HALF + n * 16) = acc[ai][bj][m][n]; }
    }
};
__device__ __forceinline__ unsigned cvt4_fp8(float a, float b, float c, float d) {
    a = __builtin_amdgcn_fmed3f(a, -448.f, 448.f); b = __builtin_amdgcn_fmed3f(b, -448.f, 448.f); c = __builtin_amdgcn_fmed3f(c, -448.f, 448.f); d = __builtin_amdgcn_fmed3f(d, -448.f, 448.f);
    unsigned w = 0u; w = __builtin_amdgcn_cvt_pk_fp8_f32(a, b, w, false); w = __builtin_amdgcn_cvt_pk_fp8_f32(c, d, w, true); return w;
}
struct EpiBf16 {
    static constexpr bool PERM = true;
    bf16_t* O; int ldc; float scale;
    __device__ __forceinline__ void operator()(const f32x4 (&acc)[2][2][4][2], const Unit& u, int wr, int wc, int fr, int fq) const {
        const int row0 = u.pm * BM + wr * 64 + fr, col0 = u.pn * BM + wc * 32 + 8 * fq;
#pragma unroll
        for (int ai = 0; ai < 2; ++ai)
#pragma unroll
            for (int m = 0; m < 4; ++m) { bf16_t* rowp = O + (size_t)(row0 + ai * HALF + m * 16) * ldc + col0;
#pragma unroll
                for (int bj = 0; bj < 2; ++bj) *(u32x4*)(rowp + bj * HALF) = pack8(acc[ai][bj][m][0] * scale, acc[ai][bj][m][1] * scale); }
    }
};
__device__ __forceinline__ float silu_f(float x) { return x * __builtin_amdgcn_rcpf(1.0f + __builtin_amdgcn_exp2f(-1.44269504089f * x)); }
template <bool F8OUT>
struct EpiSwiGLU {
    static constexpr bool PERM = true;
    bf16_t* O; int ldc;
    __device__ __forceinline__ void operator()(const f32x4 (&acc)[2][2][4][2], const Unit& u, int wr, int wc, int fr, int fq) const {
        const int row0 = u.pm * BM + wr * 64 + fr, col0 = u.pn * HALF + wc * 32 + 8 * fq;
#pragma unroll
        for (int ai = 0; ai < 2; ++ai)
#pragma unroll
            for (int m = 0; m < 4; ++m) { bf16_t* rowp = O + (size_t)(row0 + ai * HALF + m * 16) * ldc + col0;
                f32x4 v0, v1;
#pragma unroll
                for (int e = 0; e < 4; ++e) { v0[e] = silu_f(acc[ai][0][m][0][e]) * acc[ai][1][m][0][e]; v1[e] = silu_f(acc[ai][0][m][1][e]) * acc[ai][1][m][1][e]; }
                if (F8OUT) { typedef unsigned u32x2v __attribute__((ext_vector_type(2))); v0 = v0 * 16.0f; v1 = v1 * 16.0f;
                    unsigned char* bp = (unsigned char*)O + (size_t)(row0 + ai * HALF + m * 16) * ldc + col0;
                    u32x2v w; w.x = cvt4_fp8(v0[0], v0[1], v0[2], v0[3]); w.y = cvt4_fp8(v1[0], v1[1], v1[2], v1[3]); *(u32x2v*)bp = w; }
                else *(u32x4*)rowp = pack8(v0, v1); }
    }
};
struct EpiInProj {
    static constexpr bool PERM = true;
    bf16_t* O; int ldc; const float* cs; const float* sn;
    __device__ __forceinline__ void operator()(const f32x4 (&acc)[2][2][4][2], const Unit& u, int wr, int wc, int fr, int fq) const {
        const int row0 = u.pm * BM + wr * 64 + fr;
        if (u.pn < 10) {
            const int hsel = wc >> 1, ii0 = 32 * (wc & 1) + 8 * fq, col0 = u.pn * BM + 128 * hsel + ii0;
            const float* cp = cs + ii0; const float* sp = sn + ii0;
            f32x4 tc0[2], tc1[2], ts0[2], ts1[2];
            { const int pos = row0 & 2047; tc0[0] = *(const f32x4*)(cp + pos * 64); tc1[0] = *(const f32x4*)(cp + pos * 64 + 4); ts0[0] = *(const f32x4*)(sp + pos * 64); ts1[0] = *(const f32x4*)(sp + pos * 64 + 4); }
#pragma unroll
            for (int it = 0; it < 8; ++it) { const int ai = it >> 2, m = it & 3, sl = it & 1, row = row0 + ai * HALF + m * 16; bf16_t* rowp = O + (size_t)row * ldc + col0;
                if (it + 1 < 8) { const int pos = (row0 + ((it + 1) >> 2) * HALF + ((it + 1) & 3) * 16) & 2047, ns = sl ^ 1;
                    tc0[ns] = *(const f32x4*)(cp + pos * 64); tc1[ns] = *(const f32x4*)(cp + pos * 64 + 4); ts0[ns] = *(const f32x4*)(sp + pos * 64); ts1[ns] = *(const f32x4*)(sp + pos * 64 + 4); }
                const f32x4 c0 = tc0[sl], c1 = tc1[sl], s0 = ts0[sl], s1 = ts1[sl];
                const f32x4 a0 = acc[ai][0][m][0], a1 = acc[ai][0][m][1], b0 = acc[ai][1][m][0], b1 = acc[ai][1][m][1];
                *(u32x4*)rowp = pack8(a0 * c0 - b0 * s0, a1 * c1 - b1 * s1);
                *(u32x4*)(rowp + 64) = pack8(b0 * c0 + a0 * s0, b1 * c1 + a1 * s1); }
        } else {
            const int col0 = u.pn * BM + wc * 32 + 8 * fq;
#pragma unroll
            for (int ai = 0; ai < 2; ++ai)
#pragma unroll
                for (int m = 0; m < 4; ++m) { bf16_t* rowp = O + (size_t)(row0 + ai * HALF + m * 16) * ldc + col0;
#pragma unroll
                    for (int bj = 0; bj < 2; ++bj) *(u32x4*)(rowp + bj * HALF) = pack8(acc[ai][bj][m][0], acc[ai][bj][m][1]); }
        }
    }
};
struct EpiPool {
    static constexpr bool PERM = true;
    bf16_t* O; int ldc; const float* scale;
    __device__ __forceinline__ void operator()(const f32x4 (&acc)[2][2][4][2], const Unit& u, int wr, int wc, int fr, int fq) const {
        const int row0 = u.pm * BM + wr * 64 + fr, col0 = u.pn * BM + wc * 32 + 8 * fq;
        f32x4 sv[2][2];
#pragma unroll
        for (int bj = 0; bj < 2; ++bj) { sv[bj][0] = *(const f32x4*)(scale + col0 + bj * HALF); sv[bj][1] = *(const f32x4*)(scale + col0 + bj * HALF + 4); }
#pragma unroll
        for (int ai = 0; ai < 2; ++ai)
#pragma unroll
            for (int m = 0; m < 4; ++m) { bf16_t* rowp = O + (size_t)(row0 + ai * HALF + m * 16) * ldc + col0;
#pragma unroll
                for (int bj = 0; bj < 2; ++bj) *(u32x4*)(rowp + bj * HALF) = pack8(acc[ai][bj][m][0] * sv[bj][0], acc[ai][bj][m][1] * sv[bj][1]); }
    }
};

template <class Epi, class Sched, bool F8 = false, int PADV = 0, int N8 = 0>
__device__ __forceinline__ void gemm_phase(PG8_LAS unsigned char* lds, const Gemm g, const Sched& S, const Epi& E, const int wid, const int lane) {
    const int tid = wid * 64 + lane, wr = wid >> 2, wc = wid & 3, fr = lane & 15, fq = lane >> 4;
    const int K = g.K, nt = K / BK - N8;
    unsigned voffA[2], voffB[2];
#pragma unroll
    for (int i = 0; i < 2; ++i) { int R, C; stage_rc(tid * 16 + i * 8192, R, C); const int Rb = Epi::PERM ? ((R & ~31) + perm32(R & 31)) : R;
        voffA[i] = (unsigned)(R * g.lda + C) * 2u; voffB[i] = (unsigned)(Rb * g.ldb + C) * 2u; }
    const size_t kstep = (size_t)(BK * 2);
    const size_t hstepA = (size_t)HALF * g.lda * 2, hstepB = (size_t)HALF * g.ldb * 2;
    const size_t tstepA = 2 * hstepA, tstepB = 2 * hstepB;
    const unsigned ldsw = (unsigned)wid * 1024u;
    const unsigned ldsu = (unsigned)(unsigned long long)lds + ldsw;
    unsigned pa0 = (unsigned)(unsigned long long)lds + (unsigned)lds_byte(wr * 64 + fr, fq * 8), pb0 = (unsigned)(unsigned long long)lds + 4u * HTB + (unsigned)lds_byte(wc * 32 + fr, fq * 8);
    unsigned pa1 = pa0 ^ 64u, pb1 = pb0 ^ 64u;
    asm volatile("" : "+v"(pa0), "+v"(pa1), "+v"(pb0), "+v"(pb1));
#define PG8_SA(b, h) (((b) * 2 + (h)) * HTB)
#define PG8_SB(b, h) ((4 + (b) * 2 + (h)) * HTB)
#define PG8_STAGE(bufoff, gbase, voff) do { _Pragma("unroll") for (int _i = 0; _i < 2; ++_i) \
        asm volatile("s_mov_b32 m0, %2\n\ts_nop 0\n\tglobal_load_lds_dwordx4 %0, %1" :: "v"((voff)[_i]), "s"((unsigned long long)(gbase)), "s"(ldsu + (unsigned)((bufoff) + _i * 8192)) : "memory"); } while (0)
#define PG8_LDA(dst, b, h) do { _Pragma("unroll") for (int m = 0; m < 4; ++m) _Pragma("unroll") for (int k = 0; k < 2; ++k) dst[m][k] = *(const PG8_LAS bf16x8*)(unsigned long long)((k ? pa1 : pa0) + (unsigned)(PG8_SA(b, h) + m * 2048)); } while (0)
#define PG8_LDB(dst, b, h) do { _Pragma("unroll") for (int n = 0; n < 2; ++n) _Pragma("unroll") for (int k = 0; k < 2; ++k) dst[n][k] = *(const PG8_LAS bf16x8*)(unsigned long long)((k ? pb1 : pb0) + (unsigned)(PG8_SB(b, h) - 4 * HTB + n * 2048)); } while (0)
#define PG8_CAT8(lo, hi) (i32x8){(int)__builtin_bit_cast(u32x4, lo).x, (int)__builtin_bit_cast(u32x4, lo).y, (int)__builtin_bit_cast(u32x4, lo).z, (int)__builtin_bit_cast(u32x4, lo).w, \
        (int)__builtin_bit_cast(u32x4, hi).x, (int)__builtin_bit_cast(u32x4, hi).y, (int)__builtin_bit_cast(u32x4, hi).z, (int)__builtin_bit_cast(u32x4, hi).w}
#define PG8_MMA(F8X, ai, bj, At, Bt) do { __builtin_amdgcn_s_setprio(1); \
        if constexpr (F8X) { _Pragma("unroll") for (int m = 0; m < 4; ++m) _Pragma("unroll") for (int n = 0; n < 2; ++n) \
            acc[ai][bj][m][n] = __builtin_amdgcn_mfma_scale_f32_16x16x128_f8f6f4(PG8_CAT8(Bt[n][0], Bt[n][1]), PG8_CAT8(At[m][0], At[m][1]), acc[ai][bj][m][n], 0, 0, 0, 0x7f7f7f7f, 0, 0x7f7f7f7f); } \
        else { _Pragma("unroll") for (int m = 0; m < 4; ++m) _Pragma("unroll") for (int n = 0; n < 2; ++n) _Pragma("unroll") for (int k = 0; k < 2; ++k) \
            acc[ai][bj][m][n] = __builtin_amdgcn_mfma_f32_16x16x32_bf16(Bt[n][k], At[m][k], acc[ai][bj][m][n], 0, 0, 0); } \
        __builtin_amdgcn_s_setprio(0); } while (0)
#ifndef PG8_ALIGN_LOOP
#define PG8_ALIGN_LOOP asm volatile(".p2align 8" ::: "memory")
#endif
#define PG8_WAIT_V(n) asm volatile("s_waitcnt vmcnt(" #n ")" ::: "memory")
#define PG8_WAIT_L(n) asm volatile("s_waitcnt lgkmcnt(" #n ")" ::: "memory")
#define PG8_BAR __builtin_amdgcn_s_barrier()
#define PG8_SCHED __builtin_amdgcn_sched_barrier(0)
#define PG8_TOFF(t) ((size_t)((t) + ((N8 > 0 && (t) >= N8) ? N8 : 0)) * kstep)
#define PG8_KLOOP(T0, T1, F8X, LASTOK) \
        PG8_ALIGN_LOOP; \
        for (int t = (T0); t < (T1); t += 2) { \
            const bool last = (LASTOK) && (t == nt - 2); \
            const char* a1 = cA + PG8_TOFF(t + 1); \
            const char* a2 = last ? nA : cA + PG8_TOFF(t + 2); const char* b2 = last ? nB : cB + PG8_TOFF(t + 2); \
            const char* b3 = last ? nB + kstep : cB + PG8_TOFF(t + 3); \
            if (last && has_next) S.a_ready(nxt); \
              \
              \
            PG8_LDB(B0, 0, 0); PG8_LDB(B1, 0, 1); PG8_SCHED; PG8_LDA(At, 0, 0); PG8_STAGE(PG8_SA(1, 0), a1, voffA); PG8_STAGE(PG8_SA(1, 1), a1 + hstepA, voffA); \
            PG8_WAIT_V(8); PG8_WAIT_L(0); PG8_BAR; PG8_MMA(F8X, 0, 0, At, B0); PG8_MMA(F8X, 0, 1, At, B1); PG8_BAR; PG8_SCHED; \
              \
            PG8_LDA(At, 0, 1); PG8_STAGE(PG8_SB(0, 0), b2, voffB); PG8_STAGE(PG8_SB(0, 1), b2 + hstepB, voffB); \
            PG8_WAIT_V(6); PG8_WAIT_L(0); PG8_BAR; PG8_MMA(F8X, 1, 0, At, B0); PG8_MMA(F8X, 1, 1, At, B1); PG8_BAR; PG8_SCHED; \
              \
            PG8_LDB(B0, 1, 0); PG8_LDB(B1, 1, 1); PG8_SCHED; PG8_LDA(At, 1, 0); PG8_STAGE(PG8_SA(0, 0), a2, voffA); PG8_STAGE(PG8_SA(0, 1), a2 + hstepA, voffA); \
            PG8_WAIT_V(8); PG8_WAIT_L(0); PG8_BAR; PG8_MMA(F8X, 0, 0, At, B0); PG8_MMA(F8X, 0, 1, At, B1); PG8_BAR; PG8_SCHED; \
              \
            PG8_LDA(At, 1, 1); PG8_STAGE(PG8_SB(1, 0), b3, voffB); PG8_STAGE(PG8_SB(1, 1), b3 + hstepB, voffB); \
            PG8_WAIT_V(6); PG8_WAIT_L(0); PG8_BAR; PG8_MMA(F8X, 1, 0, At, B0); PG8_MMA(F8X, 1, 1, At, B1); PG8_BAR; PG8_SCHED; \
        }
    Unit cur, nxt; int ui = 0;
    if (!S.next(0, cur)) return;
    int padv[PADV ? PADV : 1];
    if constexpr (PADV > 0) { _Pragma("unroll") for (int i = 0; i < PADV; ++i) asm volatile("v_mov_b32 %0, 0" : "=v"(padv[i])); }
    f32x4 acc[2][2][4][2];
#pragma unroll
    for (int a = 0; a < 2; ++a)
#pragma unroll
        for (int b = 0; b < 2; ++b)
#pragma unroll
            for (int m = 0; m < 4; ++m)
#pragma unroll
                for (int n = 0; n < 2; ++n) acc[a][b][m][n] = (f32x4){0.f, 0.f, 0.f, 0.f};
    bf16x8 At[4][2], B0[2][2], B1[2][2];
    const char* cA = (const char*)g.A + (size_t)cur.pm * tstepA + (size_t)((cur.pn >> g.a_shift) * g.a_step) * 2; const char* cB = (const char*)g.Bt + (size_t)cur.pn * tstepB;
    S.a_ready(cur);
    PG8_STAGE(PG8_SB(0, 0), cB, voffB); PG8_STAGE(PG8_SB(0, 1), cB + hstepB, voffB); PG8_STAGE(PG8_SA(0, 0), cA, voffA); PG8_STAGE(PG8_SA(0, 1), cA + hstepA, voffA);
    if (wr == 1) PG8_BAR;
    PG8_WAIT_V(2); PG8_BAR;
    PG8_STAGE(PG8_SB(1, 0), cB + kstep, voffB); PG8_STAGE(PG8_SB(1, 1), cB + hstepB + kstep, voffB);
    PG8_WAIT_V(4); PG8_BAR;
    for (;;) {
        const bool has_next = S.next(ui + 1, nxt);
        const char* nA = has_next ? (const char*)g.A + (size_t)nxt.pm * tstepA + (size_t)((nxt.pn >> g.a_shift) * g.a_step) * 2 : cA; const char* nB = has_next ? (const char*)g.Bt + (size_t)nxt.pn * tstepB : cB;
        if constexpr (N8 > 0) {
            PG8_KLOOP(0, N8, true, false)
#pragma unroll
            for (int a = 0; a < 2; ++a)
#pragma unroll
                for (int b = 0; b < 2; ++b)
#pragma unroll
                    for (int m = 0; m < 4; ++m)
#pragma unroll
                        for (int n = 0; n < 2; ++n) acc[a][b][m][n] = acc[a][b][m][n] * (1.0f / 1024.0f);
            PG8_KLOOP(N8, nt, false, true)
        } else { PG8_KLOOP(0, nt, F8, true) }
        if (wr == 0) PG8_BAR;
        E(acc, cur, wr, wc, fr, fq); S.done(cur);
        if (!has_next) break;
#pragma unroll
        for (int a = 0; a < 2; ++a)
#pragma unroll
            for (int b = 0; b < 2; ++b)
#pragma unroll
                for (int m = 0; m < 4; ++m)
#pragma unroll
                    for (int n = 0; n < 2; ++n) acc[a][b][m][n] = (f32x4){0.f, 0.f, 0.f, 0.f};
        cur = nxt; cA = nA; cB = nB; ++ui;
        if (wr == 1) PG8_BAR;
    }
    PG8_WAIT_V(0);
    PG8_BAR;
    if constexpr (PADV > 0) { _Pragma("unroll") for (int i = 0; i < PADV; ++i) asm volatile("" :: "v"(padv[i])); }
#undef PG8_SA
#undef PG8_SB
#undef PG8_STAGE
#undef PG8_LDA
#undef PG8_LDB
#undef PG8_MMA
#undef PG8_KLOOP
#undef PG8_TOFF
#undef PG8_CAT8
#undef PG8_WAIT_V
#undef PG8_WAIT_L
#undef PG8_BAR
#undef PG8_SCHED
}
}

constexpr int NWAVES = 8;
constexpr int BATCH = 4, SEQ = 2048, D = 4096, M = BATCH * SEQ;
constexpr int HD = 128, NH = 16, NKV = 4, ATTW = 2048, KVW = 512, POOLW = 2048, PGW = 512, INW = 5120, FF = 11008;
constexpr float RMS_EPS = 1e-6f;
constexpr int N_PHASES = 12;
constexpr int P9_N8 = 4, P9_PAD = 2;

constexpr size_t MiB = 1u << 20;
constexpr size_t WS_CTL = 0, CTL_ZERO_BYTES = 1 * MiB;
constexpr size_t WS_COS = 1 * MiB, WS_SIN = WS_COS + 512 * 1024;
constexpr size_t WS_WGU1 = 2 * MiB;
constexpr size_t WS_WD1 = WS_WGU1 + 172 * MiB;
constexpr size_t WS_WIN = WS_WD1 + 86 * MiB;
constexpr size_t WS_WOUT = WS_WIN + 40 * MiB;
constexpr size_t WS_WPOOL = WS_WOUT + 32 * MiB;
constexpr size_t WS_WGU2 = WS_WPOOL + 2 * MiB;
constexpr size_t WS_WD2 = WS_WGU2 + 172 * MiB;
constexpr size_t WS_XN = WS_WD2 + 86 * MiB;
constexpr size_t WS_ACT = WS_XN + 64 * MiB;
constexpr size_t WS_HF = WS_ACT + 172 * MiB;
constexpr size_t WS_PROJ = WS_HF + 128 * MiB;
constexpr size_t WS_MIX = WS_PROJ + 80 * MiB;
constexpr size_t WS_YP = WS_MIX + 64 * MiB;
constexpr size_t WS_END = WS_YP + 32 * MiB;
static_assert((size_t)2 * FF * D * 2 == 172 * MiB && (size_t)D * FF * 2 == 86 * MiB && (size_t)M * FF * 2 == 172 * MiB, "sizes");
constexpr int CW_BAR = 4096;

constexpr int RING_OFF = 0, RING_BYTES = 131072;
constexpr int LDSCTL_OFF = RING_BYTES, MISC_OFF = LDSCTL_OFF + 320;
constexpr int LDS_BYTES = 147456;
constexpr int GAIN_OFF = 98304;
static_assert(MISC_OFF + 128 <= LDS_BYTES, "LDS map");

#define GAS __attribute__((address_space(1)))
#define LAS __attribute__((address_space(3)))
typedef unsigned short bf16;
typedef unsigned v4u __attribute__((ext_vector_type(4)));
typedef unsigned v2u __attribute__((ext_vector_type(2)));
typedef float f32x4 __attribute__((ext_vector_type(4)));
typedef float f32x16 __attribute__((ext_vector_type(16)));
typedef short bf16x8 __attribute__((ext_vector_type(8)));
typedef GAS unsigned gu32;
#define RLX_AGENT __ATOMIC_RELAXED, __HIP_MEMORY_SCOPE_AGENT
#define LDS_WAIT() asm volatile("s_waitcnt lgkmcnt(0)" ::: "memory")
#define VM_WAIT() asm volatile("s_waitcnt vmcnt(0)" ::: "memory")
__device__ __forceinline__ unsigned f2bf(float f) { unsigned u = __builtin_bit_cast(unsigned, f); return (u + 0x7fffu + ((u >> 16) & 1u)) >> 16; }
__device__ __forceinline__ unsigned pk2(float lo, float hi) { return f2bf(lo) | (f2bf(hi) << 16); }
__device__ __forceinline__ float bf_lo(unsigned w) { return __builtin_bit_cast(float, w << 16); }
__device__ __forceinline__ float bf_hi(unsigned w) { return __builtin_bit_cast(float, w & 0xffff0000u); }

#define XB_TMO      128
#define XB_XCNT(j)  (256  + 64 * (j))
#define XB_XSUB(j)  (1280 + 64 * (j))
#define XB_XGEN(j)  (2304 + 64 * (j))
#define XB_TOP      3328
#define XB_TOPGEN   3392
#define XCD_BAR_WORDS 3456
#define XB_SPIN_CAP (1u << 18)

__device__ __forceinline__ unsigned xb_ld(unsigned* p)              { return __hip_atomic_load(p, __ATOMIC_RELAXED, __HIP_MEMORY_SCOPE_AGENT); }
__device__ __forceinline__ unsigned xb_add(unsigned* p, unsigned v) { return __hip_atomic_fetch_add(p, v, __ATOMIC_RELAXED, __HIP_MEMORY_SCOPE_AGENT); }
__device__ __forceinline__ unsigned xb_xcc_id() { return (unsigned)__builtin_amdgcn_s_getreg((3 << 11) | 20) & 0xFu; }
#define XB_SPIN(cond, bar) do { unsigned _sp = 0; while (cond) { __builtin_amdgcn_s_sleep(1); \
    if ((++_sp & 255u) == 0u) { if (xb_ld(&(bar)[XB_TMO])) break; if (_sp > XB_SPIN_CAP) { atomicAdd(&(bar)[XB_TMO], 1u); break; } } } } while (0)

struct XcdBarrier {
    unsigned* bar; unsigned x;
    volatile LAS unsigned* st;
};
__device__ __forceinline__ XcdBarrier xcd_barrier_post(unsigned* bar, volatile LAS unsigned* st) {
    XcdBarrier b; b.bar = bar; b.x = xb_xcc_id(); b.st = st;
    if (threadIdx.x == 0) (void)xb_add(&bar[XB_XCNT(b.x)], 1u);
    return b;
}
__device__ __forceinline__ void xcd_barrier_complete(unsigned* bar, unsigned x, unsigned& nloc, unsigned& nx) {
    const unsigned G = gridDim.x * gridDim.y * gridDim.z;
    unsigned sum, cnt, mine, sp = 0u;
    for (;;) {
        sum = 0u; cnt = 0u; mine = 0u;
#pragma unroll
        for (unsigned j = 0; j < 16; ++j) { const unsigned c = xb_ld(&bar[XB_XCNT(j)]); sum += c; cnt += (c > 0u) ? 1u : 0u; mine = (j == x) ? c : mine; }
        if (sum == G) break;
        __builtin_amdgcn_s_sleep(1);
        if ((++sp & 255u) == 0u) { if (xb_ld(&bar[XB_TMO])) break; if (sp > XB_SPIN_CAP) { atomicAdd(&bar[XB_TMO], 1u); break; } }
    }
    nloc = mine > 0u ? mine : 1u; nx = cnt > 0u ? cnt : 1u;
}
__device__ __forceinline__ void xcd_barrier(const XcdBarrier& b) {
    asm volatile("s_waitcnt vmcnt(0)" ::: "memory");
    __syncthreads();
    if (threadIdx.x == 0) {
        unsigned* bar = b.bar;
        __builtin_amdgcn_s_waitcnt(0);
        unsigned nloc = b.st[0], nx = b.st[1];
        if (nloc == 0u) { xcd_barrier_complete(bar, b.x, nloc, nx); b.st[0] = nloc; b.st[1] = nx; }
        const unsigned old = xb_add(&bar[XB_XSUB(b.x)], 1u);
        const unsigned gen = old / nloc;
        if (old + 1u == (gen + 1u) * nloc) {
            __builtin_amdgcn_fence(__ATOMIC_RELEASE, "agent");
            asm volatile("s_waitcnt vmcnt(0)" ::: "memory");
            const unsigned og = xb_add(&bar[XB_TOP], 1u);
            const unsigned tg = og / nx;
            if (og + 1u == (tg + 1u) * nx) xb_add(&bar[XB_TOPGEN], 1u);
            else XB_SPIN(xb_ld(&bar[XB_TOPGEN]) == tg, bar);
            __builtin_amdgcn_fence(__ATOMIC_ACQUIRE, "agent");
            xb_add(&bar[XB_XGEN(b.x)], 1u);
            asm volatile("s_waitcnt vmcnt(0)" ::: "memory");
        } else {
            XB_SPIN(xb_ld(&bar[XB_XGEN(b.x)]) == gen, bar);
            __builtin_amdgcn_fence(__ATOMIC_ACQUIRE, "agent");
            asm volatile("s_waitcnt vmcnt(0)" ::: "memory");
        }
    }
    __syncthreads();
}

__device__ __forceinline__ int lane_id_v() { int l; asm volatile("v_mbcnt_lo_u32_b32 %0, -1, 0\n\tv_mbcnt_hi_u32_b32 %0, -1, %0" : "=v"(l)); return l; }
__device__ __forceinline__ float wave_sum(float v) {
#pragma unroll
    for (int o = 1; o < 64; o <<= 1) v += __shfl_xor(v, o);
    return v;
}
__device__ __forceinline__ void cvt_item(const float* W, int N, int k0, int n0, bf16* WT, int ldk, int drow0, LAS float* scr, int lane, int f8 = 0  ) {
    float v[32];
    const GAS float* src = (const GAS float*)W + (size_t)(k0 + (lane >> 5)) * N + n0 + (lane & 31);
#pragma unroll
    for (int i = 0; i < 32; ++i) v[i] = __builtin_nontemporal_load(src + (size_t)(2 * i) * N);
#pragma unroll
    for (int i = 0; i < 32; ++i) scr[(2 * i + (lane >> 5)) * 33 + (lane & 31)] = v[i];
    LDS_WAIT(); asm volatile("" ::: "memory");
    const int c = lane & 7;
#pragma unroll
    for (int j = 0; j < 4; ++j) { const int n = (lane >> 3) + 8 * j; const LAS float* s = scr + (8 * c) * 33 + n;
        const size_t eo = (size_t)(drow0 + n) * ldk + k0 + 8 * c;
        if (f8) { typedef unsigned v2u __attribute__((ext_vector_type(2))); v2u o; o.x = pg8::cvt4_fp8(64.f * s[0 * 33], 64.f * s[1 * 33], 64.f * s[2 * 33], 64.f * s[3 * 33]); o.y = pg8::cvt4_fp8(64.f * s[4 * 33], 64.f * s[5 * 33], 64.f * s[6 * 33], 64.f * s[7 * 33]);
            *(GAS v2u*)((GAS unsigned char*)WT + (size_t)(drow0 + n) * f8 + k0 + 8 * c) = o; }
        else { v4u o; o.x = pk2(s[0 * 33], s[1 * 33]); o.y = pk2(s[2 * 33], s[3 * 33]); o.z = pk2(s[4 * 33], s[5 * 33]); o.w = pk2(s[6 * 33], s[7 * 33]);
            *(GAS v4u*)(WT + eo) = o; } }
    LDS_WAIT(); asm volatile("" ::: "memory");
}
__device__ __forceinline__ int drow_gu(int n0, int up) { return 256 * (n0 >> 7) + 128 * up + (n0 & 127); }
__device__ __forceinline__ int drow_in(int n0) { if (n0 >= 2560) return n0; const int pn = n0 >> 8, rem = n0 & 255, hsel = rem >> 7, r2 = rem & 127, bj = r2 >> 6, ii = r2 & 63; return 256 * pn + 128 * bj + 64 * hsel + ii; }

template <bool HAS_H, bool XIN_BF16, int WRITE_X  , bool WRITE_XN, int XN_F8J = 0  >
__device__ __forceinline__ void norm_row(const bf16* hrow, const void* xrow, void* xout, bf16* xn, float w, const LAS float* gpost, const LAS float* gpre, int lane) {
    asm volatile("" ::: "memory");
    f32x4 xv[16];
    if (XIN_BF16) { const GAS v2u* xr = (const GAS v2u*)xrow + lane;
#pragma unroll
        for (int j = 0; j < 16; ++j) { const v2u q = __builtin_nontemporal_load(xr + 64 * j); xv[j] = (f32x4){bf_lo(q.x), bf_hi(q.x), bf_lo(q.y), bf_hi(q.y)}; }
    } else { const GAS f32x4* xr = (const GAS f32x4*)xrow + lane;
#pragma unroll
        for (int j = 0; j < 16; ++j) xv[j] = __builtin_nontemporal_load(xr + 64 * j); }
    if (HAS_H) {
        f32x4 hv[16]; const GAS v2u* hr = (const GAS v2u*)hrow + lane; float s = 0.f;
#pragma unroll
        for (int j = 0; j < 16; ++j) { const v2u q = __builtin_nontemporal_load(hr + 64 * j); hv[j] = (f32x4){bf_lo(q.x), bf_hi(q.x), bf_lo(q.y), bf_hi(q.y)}; }
#pragma unroll
        for (int j = 0; j < 16; ++j) s += (hv[j].x * hv[j].x + hv[j].y * hv[j].y) + (hv[j].z * hv[j].z + hv[j].w * hv[j].w);
        const float rstd = w / sqrtf(wave_sum(s) * (1.f / D) + RMS_EPS);
#pragma unroll
        for (int j = 0; j < 16; ++j) { const f32x4 gg = *(const LAS f32x4*)(gpost + 4 * lane + 256 * j); xv[j] = xv[j] + hv[j] * rstd * gg; }
        if (WRITE_X == 1) { GAS f32x4* xo = (GAS f32x4*)xout + lane;
#pragma unroll
            for (int j = 0; j < 16; ++j) __builtin_nontemporal_store(xv[j], xo + 64 * j); }
        if (WRITE_X == 2) { GAS v2u* xo = (GAS v2u*)xout + lane;
#pragma unroll
            for (int j = 0; j < 16; ++j) { v2u pk; pk.x = pk2(xv[j].x, xv[j].y); pk.y = pk2(xv[j].z, xv[j].w); __builtin_nontemporal_store(pk, xo + 64 * j); } }
    }
    if (WRITE_XN) {
        float s2 = 0.f;
#pragma unroll
        for (int j = 0; j < 16; ++j) s2 += (xv[j].x * xv[j].x + xv[j].y * xv[j].y) + (xv[j].z * xv[j].z + xv[j].w * xv[j].w);
        const float rstd2 = 1.f / sqrtf(wave_sum(s2) * (1.f / D) + RMS_EPS);
        GAS v2u* o8 = (GAS v2u*)xn + lane;
#pragma unroll
        for (int j = 0; j < 16; ++j) { const f32x4 gg = *(const LAS f32x4*)(gpre + 4 * lane + 256 * j); const f32x4 o = xv[j] * rstd2 * gg;
            if (j < XN_F8J) ((GAS unsigned*)xn)[64 * j + lane] = pg8::cvt4_fp8(16.f * o.x, 16.f * o.y, 16.f * o.z, 16.f * o.w);
            else { v2u pk; pk.x = pk2(o.x, o.y); pk.y = pk2(o.z, o.w); o8[64 * j] = pk; } }
    }
}

template <int W, bool FIRST>
__device__ __forceinline__ void pool_item(const bf16* proj, bf16* yp, int g, int row0, int lane) {
#pragma unroll
    for (int sub = 0; sub < 2; ++sub) {
        v4u r[W + 7];
        const GAS v4u* src = (const GAS v4u*)(proj + (size_t)(row0 + 8 * sub) * INW + (ATTW + 2 * KVW) + PGW * g + 8 * lane);
#pragma unroll
        for (int i = 0; i < W + 7; ++i) { const int d = i - (W - 1); if (FIRST && 8 * sub + d < 0) r[i] = (v4u){0u, 0u, 0u, 0u}; else r[i] = src[(long)d * (INW / 8)]; }
        GAS v4u* dst = (GAS v4u*)(yp + (size_t)(row0 + 8 * sub) * POOLW + PGW * g + 8 * lane);
#pragma unroll
        for (int k = 0; k < 8; ++k) {
            float a[8] = {0.f, 0.f, 0.f, 0.f, 0.f, 0.f, 0.f, 0.f};
#pragma unroll
            for (int j = 0; j < W; ++j) { if (FIRST && 8 * sub + k + j < W - 1) continue; const v4u q = r[k + j]; a[0] += bf_lo(q.x); a[1] += bf_hi(q.x); a[2] += bf_lo(q.y); a[3] += bf_hi(q.y); a[4] += bf_lo(q.z); a[5] += bf_hi(q.z); a[6] += bf_lo(q.w); a[7] += bf_hi(q.w); }
            const int cnt = (FIRST && 8 * sub + k + 1 < W) ? (8 * sub + k + 1) : W; const float ic = 1.0f / (float)cnt; const v4u p = r[k + W - 1];
            v4u o; o.x = pk2(a[0] * ic - bf_lo(p.x), a[1] * ic - bf_hi(p.x)); o.y = pk2(a[2] * ic - bf_lo(p.y), a[3] * ic - bf_hi(p.y));
            o.z = pk2(a[4] * ic - bf_lo(p.z), a[5] * ic - bf_hi(p.z)); o.w = pk2(a[6] * ic - bf_lo(p.w), a[7] * ic - bf_hi(p.w));
            dst[(size_t)k * (POOLW / 8)] = o;
        }
        asm volatile("" ::: "memory");
    }
}
template <int W>
__device__ __forceinline__ void pool_item2(const bf16* proj, bf16* yp, int g, int row0, int lane) {
    if ((row0 & (SEQ - 1)) == 0) pool_item<W, true>(proj, yp, g, row0, lane); else pool_item<W, false>(proj, yp, g, row0, lane);
}

constexpr int AT_KROWS = 192, AT_KSTR = 272, AT_VSTR = 392, AT_K_OFF = 0, AT_VT_OFF = AT_KROWS * AT_KSTR;
static_assert(AT_VT_OFF + 128 * AT_VSTR <= RING_BYTES, "attention LDS");
__device__ __forceinline__ void attn_unit(LAS unsigned char* lds, const bf16* proj, bf16* mix, const float* sinks, int unit, int tid, int wid) {
    asm volatile("" : "+v"(tid));
    const int lane = tid & 63;
    const int b = unit >> 7, kvh = (unit >> 5) & 3, qb = unit & 31, q0 = qb * 64, rowbase = b * SEQ;
#pragma unroll
    for (int i = 0; i < 6; ++i) { const int c = tid + 512 * i, key = c >> 4, ch = c & 15; int kp = q0 - 128 + key; kp = kp < 0 ? 0 : kp;
        const v4u v = *(const GAS v4u*)(proj + (size_t)(rowbase + kp) * INW + ATTW + kvh * HD + ch * 8);
        *(LAS v4u*)(lds + AT_K_OFF + key * AT_KSTR + ch * 16) = v; }
#pragma unroll
    for (int i = 0; i < 6; ++i) { const int c = tid + 512 * i, ch = c / 192, key = c - ch * 192; int kp = q0 - 128 + key; kp = kp < 0 ? 0 : kp;
        const v4u v = *(const GAS v4u*)(proj + (size_t)(rowbase + kp) * INW + ATTW + KVW + kvh * HD + ch * 8);
        LAS unsigned short* d = (LAS unsigned short*)(lds + AT_VT_OFF + (ch * 8) * AT_VSTR + key * 2);
        d[0 * (AT_VSTR / 2)] = (unsigned short)(v.x & 0xffffu); d[1 * (AT_VSTR / 2)] = (unsigned short)(v.x >> 16);
        d[2 * (AT_VSTR / 2)] = (unsigned short)(v.y & 0xffffu); d[3 * (AT_VSTR / 2)] = (unsigned short)(v.y >> 16);
        d[4 * (AT_VSTR / 2)] = (unsigned short)(v.z & 0xffffu); d[5 * (AT_VSTR / 2)] = (unsigned short)(v.z >> 16);
        d[6 * (AT_VSTR / 2)] = (unsigned short)(v.w & 0xffffu); d[7 * (AT_VSTR / 2)] = (unsigned short)(v.w >> 16); }
    __syncthreads();
    const int hq = kvh * 4 + (wid >> 1), s = wid & 1, ql = lane & 31, h = lane >> 5;
    const int qrow = rowbase + q0 + 32 * s + ql;
    bf16x8 qf[8];
#pragma unroll
    for (int kk = 0; kk < 8; ++kk) qf[kk] = *(const GAS bf16x8*)(proj + (size_t)qrow * INW + hq * HD + 16 * kk + 8 * h);
    f32x16 sc[5];
#pragma unroll
    for (int kt = 0; kt < 5; ++kt) {
        f32x16 a; for (int r = 0; r < 16; ++r) a[r] = 0.f;
#pragma unroll
        for (int kk = 0; kk < 8; ++kk) { const bf16x8 kf = *(const LAS bf16x8*)(lds + AT_K_OFF + (32 * (s + kt) + ql) * AT_KSTR + (16 * kk + 8 * h) * 2);
            a = __builtin_amdgcn_mfma_f32_32x32x16_bf16(kf, qf[kk], a, 0, 0, 0); }
        sc[kt] = a;
    }
    const float sc2 = 0.08838834764831845f * 1.4426950408889634f;
    const float sink2 = sinks[hq] * 1.4426950408889634f;
    float mx = -__builtin_inff();
    const int tmin = 4 - 2 * qb;
#pragma unroll
    for (int kt = 0; kt < 5; ++kt) {
        const bool tile_ok = (s + kt) >= tmin;
#pragma unroll
        for (int r = 0; r < 16; ++r) { const int koff = (r & 3) + 8 * (r >> 2) + 4 * h;
            bool valid = tile_ok; if (kt == 0) valid = valid && (koff > ql); if (kt == 4) valid = valid && (koff <= ql);
            const float v = valid ? sc[kt][r] * sc2 : -__builtin_inff(); sc[kt][r] = v; mx = fmaxf(mx, v); }
    }
    mx = fmaxf(mx, __shfl_xor(mx, 32)); mx = fmaxf(mx, sink2);
    float sum = 0.f;
#pragma unroll
    for (int kt = 0; kt < 5; ++kt)
#pragma unroll
        for (int r = 0; r < 16; ++r) { const float e = __builtin_amdgcn_exp2f(sc[kt][r] - mx); sc[kt][r] = e; sum += e; }
    sum += __shfl_xor(sum, 32);
    const float inv = 1.0f / (sum + __builtin_amdgcn_exp2f(sink2 - mx));
    f32x16 oacc[4];
#pragma unroll
    for (int dt = 0; dt < 4; ++dt) for (int r = 0; r < 16; ++r) oacc[dt][r] = 0.f;
#pragma unroll
    for (int kt = 0; kt < 5; ++kt)
#pragma unroll
        for (int s2 = 0; s2 < 2; ++s2) {
            v4u pw; pw.x = pg8::cvt_pk_bf16(sc[kt][8 * s2 + 0], sc[kt][8 * s2 + 1]); pw.y = pg8::cvt_pk_bf16(sc[kt][8 * s2 + 2], sc[kt][8 * s2 + 3]);
            pw.z = pg8::cvt_pk_bf16(sc[kt][8 * s2 + 4], sc[kt][8 * s2 + 5]); pw.w = pg8::cvt_pk_bf16(sc[kt][8 * s2 + 6], sc[kt][8 * s2 + 7]);
            const bf16x8 pf = __builtin_bit_cast(bf16x8, pw);
#pragma unroll
            for (int dt = 0; dt < 4; ++dt) { const LAS unsigned char* vb = lds + AT_VT_OFF + (32 * dt + ql) * AT_VSTR + (32 * (s + kt) + 16 * s2 + 4 * h) * 2;
                const v2u lo = *(const LAS v2u*)vb, hi = *(const LAS v2u*)(vb + 16);
                v4u vw; vw.x = lo.x; vw.y = lo.y; vw.z = hi.x; vw.w = hi.y;
                oacc[dt] = __builtin_amdgcn_mfma_f32_32x32x16_bf16(__builtin_bit_cast(bf16x8, vw), pf, oacc[dt], 0, 0, 0); }
        }
    bf16* orow = mix + (size_t)qrow * D + hq * HD;
#pragma unroll
    for (int dt = 0; dt < 4; ++dt)
#pragma unroll
        for (int g4 = 0; g4 < 4; ++g4) { v2u o; o.x = pg8::cvt_pk_bf16(oacc[dt][4 * g4 + 0] * inv, oacc[dt][4 * g4 + 1] * inv); o.y = pg8::cvt_pk_bf16(oacc[dt][4 * g4 + 2] * inv, oacc[dt][4 * g4 + 3] * inv);
            *(GAS v2u*)(orow + 32 * dt + 8 * g4 + 4 * h) = o; }
    __syncthreads();
}

__device__ const double INV_FREQ[64] = {
    1.0, 0.8659643233600653, 0.7498942093324559, 0.6493816315762113, 0.5623413251903491, 0.4869675251658631, 0.4216965034285822, 0.3651741272548377, 0.31622776601683794, 0.27384196342643613, 0.23713737056616552, 0.2053525026457146, 0.1778279410038923, 0.1539926526059492, 0.1333521432163324, 0.11547819846894582,
    0.1, 0.08659643233600653, 0.07498942093324558, 0.06493816315762113, 0.05623413251903491, 0.04869675251658631, 0.042169650342858224, 0.03651741272548377, 0.03162277660168379, 0.027384196342643614, 0.023713737056616554, 0.02053525026457146, 0.01778279410038923, 0.01539926526059492, 0.01333521432163324, 0.011547819846894581,
    0.01, 0.008659643233600654, 0.007498942093324558, 0.006493816315762113, 0.005623413251903491, 0.004869675251658631, 0.004216965034285823, 0.003651741272548377, 0.0031622776601683794, 0.0027384196342643613, 0.0023713737056616554, 0.002053525026457146, 0.0017782794100389228, 0.001539926526059492, 0.001333521432163324, 0.0011547819846894581,
    0.001, 0.0008659643233600654, 0.0007498942093324559, 0.0006493816315762113, 0.0005623413251903491, 0.0004869675251658631, 0.00042169650342858224, 0.0003651741272548377, 0.00031622776601683794, 0.0002738419634264361, 0.00023713737056616554, 0.0002053525026457146, 0.00017782794100389227, 0.0001539926526059492, 0.0001333521432163324, 0.00011547819846894582};
__device__ __forceinline__ void sincos_d(double a, double& sn, double& cs) {
    const double k = __builtin_rint(a * 0.6366197723675814);
    double r = __builtin_fma(-k, 1.5707963267948966, a); r = __builtin_fma(-k, 6.123233995736766e-17, r);
    const double r2 = r * r;
    double sp = -7.647163731819816e-13; sp = sp * r2 + 1.6059043836821613e-10; sp = sp * r2 - 2.505210838544172e-08; sp = sp * r2 + 2.7557319223985893e-06; sp = sp * r2 - 0.0001984126984126984; sp = sp * r2 + 0.008333333333333333; sp = sp * r2 - 0.16666666666666666; sp = r + r * r2 * sp;
    double cp = 4.779477332387385e-14; cp = cp * r2 - 1.1470745597729725e-11; cp = cp * r2 + 2.08767569878681e-09; cp = cp * r2 - 2.755731922398589e-07; cp = cp * r2 + 2.48015873015873e-05; cp = cp * r2 - 0.001388888888888889; cp = cp * r2 + 0.041666666666666664; cp = cp * r2 - 0.5; cp = 1.0 + r2 * cp;
    const int q = ((int)k) & 3;
    sn = (q == 0) ? sp : (q == 1) ? cp : (q == 2) ? -sp : -cp;
    cs = (q == 0) ? cp : (q == 1) ? -sp : (q == 2) ? -cp : sp;
}

struct Args { const float* in[18]; float* out; unsigned char* ws; int ph_lo, ph_hi; };
static_assert(sizeof(Args) == 18 * 8 + 8 + 8 + 8, "Args has no padding");

constexpr int I_G = (D / 64) * (FF / 32), I_D = (FF / 64) * (D / 32), I_IN = (D / 64) * (INW / 32), I_OUT = (D / 64) * (D / 32), I_P = (PGW / 64) * (PGW / 32);
static_assert(I_D == I_G, "items");
constexpr int CV_R0 = 2 * I_G, CV_R1 = CV_R0 + I_D + I_IN, CV_R2 = CV_R1 + I_OUT + 4 * I_P + 2 * I_G, CV_R3 = CV_R2 + I_D;
__device__ __forceinline__ void cvt_any(const Args& args, int it, LAS float* scr, int lane) {
    int r = it, idx, N, ldk, kind = 0, nshift = 0; size_t dst; size_t soff = 0; int f8 = 0;
    if (r < CV_R0) { const int up = r >= I_G; r -= up * I_G; idx = 2 + up; N = FF; ldk = D; dst = WS_WGU1; kind = 1 + up; }
    else if ((r -= CV_R0) < I_D) { idx = 4; N = D; ldk = FF; dst = WS_WD1; }
    else if ((r -= I_D) < I_IN) { idx = 7; N = INW; ldk = D; dst = WS_WIN; kind = 3; }
    else if ((r -= I_IN) < I_OUT) { idx = 11; N = D; ldk = D; dst = WS_WOUT; }
    else if ((r -= I_OUT) < 4 * I_P) { const int gq = r / I_P; r -= gq * I_P; idx = 9; N = PGW; ldk = PGW; dst = WS_WPOOL; soff = (size_t)gq * PGW * PGW; nshift = PGW * gq; }
    else if ((r -= 4 * I_P) < 2 * I_G) { const int up = r >= I_G; r -= up * I_G; idx = 14 + up; N = FF; ldk = D; dst = WS_WGU2; kind = 1 + up; }
    else { r -= 2 * I_G; idx = 16; N = D; ldk = FF; dst = WS_WD2; f8 = FF; }
    const int nblk = N >> 5, kb = r / nblk, nb = r - kb * nblk, n0 = 32 * nb;
    if (idx >= 14 && idx <= 15 && 64 * kb < 128 * P9_N8) f8 = 2 * D;
    const int drow = (kind == 0) ? (nshift + n0) : (kind == 3) ? drow_in(n0) : drow_gu(n0, kind - 1);
    cvt_item(args.in[idx] + soff, N, 64 * kb, n0, (bf16*)(args.ws + dst), ldk, drow, scr, lane, f8);
}
constexpr int CW_Q1 = 1024, CW_Q2 = 1088, CW_Q3 = 1152;

__global__ void __launch_bounds__(NWAVES * 64, 2) hymba_fwd(Args args) {
    extern __shared__ __attribute__((aligned(16))) unsigned char lds_raw[];
    LAS unsigned char* lds = (LAS unsigned char*)lds_raw;
    volatile LAS unsigned* MISC = (volatile LAS unsigned*)(lds + MISC_OFF);
    const int wave = __builtin_amdgcn_readfirstlane((int)threadIdx.x >> 6);
#define PH_IDS const int lane = lane_id_v(), tid = wave * 64 + lane; (void)tid
    const int G = gridDim.x; const int bx = blockIdx.x; const int vcu = (G % 8 == 0) ? (bx % 8) * (G / 8) + bx / 8 : bx;
    const int gw = vcu * NWAVES + wave, NGW = G * NWAVES;
    gu32* ctl = (gu32*)(args.ws + WS_CTL);
#define WSP(T, off) ((T*)(args.ws + (off)))
#define WGU1 WSP(bf16, WS_WGU1)
#define WD1 WSP(bf16, WS_WD1)
#define WIN WSP(bf16, WS_WIN)
#define WOUT WSP(bf16, WS_WOUT)
#define WPOOL WSP(bf16, WS_WPOOL)
#define WGU2 WSP(bf16, WS_WGU2)
#define WD2 WSP(bf16, WS_WD2)
#define XN WSP(bf16, WS_XN)
#define ACT WSP(bf16, WS_ACT)
#define HF WSP(bf16, WS_HF)
#define XRES WSP(bf16, WS_HF + 64 * MiB)
#define PROJ WSP(bf16, WS_PROJ)
#define MIX WSP(bf16, WS_MIX)
#define YP WSP(bf16, WS_YP)
#define COS WSP(float, WS_COS)
#define SIN WSP(float, WS_SIN)
#define XIN (args.in[0])
#define OUTP (args.out)
    LAS float* gA = (LAS float*)(lds + GAIN_OFF); LAS float* gB = (LAS float*)(lds + GAIN_OFF + 16384);

    for (int u = threadIdx.x; u < (LDS_BYTES - LDSCTL_OFF) / 4; u += NWAVES * 64) ((LAS unsigned*)(lds + LDSCTL_OFF))[u] = 0u;
    __syncthreads();
    XcdBarrier bar; bar.bar = (unsigned*)(ctl + CW_BAR); bar.x = 0; bar.st = nullptr;
    if (!MK_SPLIT) bar = xcd_barrier_post((unsigned*)(ctl + CW_BAR), MISC + 8);
    const int lo = args.ph_lo, hi = args.ph_hi;
#ifndef REPMASK
#define REPMASK 0
#endif
#define NREP(k) (((REPMASK >> (k)) & 1) ? 2 : 1)
#ifndef PHMASK
#define PHMASK 0xfff
#endif
#define IN(k) (((PHMASK >> (k)) & 1) && lo <= (k) && (k) < hi)
#define SEAM(k) do { if (IN(k) && IN((k) + 1)) xcd_barrier(bar); } while (0)
#define LOAD_GAINS(pa, pb) do { for (int _u = tid; _u < D / 4; _u += NWAVES * 64) { ((LAS f32x4*)gA)[_u] = ((const GAS f32x4*)(pa))[_u]; ((LAS f32x4*)gB)[_u] = ((const GAS f32x4*)(pb))[_u]; } __syncthreads(); } while (0)

#define CVT_QUEUE(qword, lo_it, hi_it) do { LAS float* scr_ = (LAS float*)(lds + RING_OFF + wave * 8448); \
        for (;;) { if (tid == 0) MISC[0] = (unsigned)(lo_it) + __hip_atomic_fetch_add((unsigned*)(ctl + (qword)), 32u, __ATOMIC_RELAXED, __HIP_MEMORY_SCOPE_AGENT); \
            __syncthreads(); const int base_ = (int)MISC[0]; __syncthreads(); if (base_ >= (hi_it)) break; \
            _Pragma("unroll 1") for (int j_ = 0; j_ < 4; ++j_) { const int it_ = base_ + wave * 4 + j_; if (it_ < (hi_it)) cvt_any(args, it_, scr_, lane); } } } while (0)
    if (IN(0)) for (int rep_ = 0; rep_ < NREP(0); ++rep_) {
        PH_IDS;
        for (int i = gw * 64 + lane; i < SEQ * 64; i += NGW * 64) { const int pos = i >> 6, f = i & 63; double sn, cs; sincos_d((double)pos * INV_FREQ[f], sn, cs); WSP(float, WS_COS)[i] = (float)cs; WSP(float, WS_SIN)[i] = (float)sn; }
        LOAD_GAINS(args.in[1], args.in[1]);
#pragma unroll 1
        for (int m = gw; m < M; m += NGW) norm_row<false, false, 0, true>(nullptr, XIN + (size_t)m * D, nullptr, XN + (size_t)m * D, 0.f, gA, gB, lane);
        LAS float* scr = (LAS float*)(lds + RING_OFF + wave * 8448);
#pragma unroll 1
        for (int it = gw; it < CV_R0; it += NGW) cvt_any(args, it, scr, lane);
        __syncthreads();
    }
    SEAM(0);
    if (IN(1)) for (int rep_ = 0; rep_ < NREP(1); ++rep_) {
        PH_IDS;
        pg8::Gemm g{XN, WGU1, M, 2 * FF, D, D, D, 0, 0}; pg8::StaticOrder S; S.init(M, 2 * FF, G, bx);
        pg8::EpiSwiGLU<false> E{ACT, FF};
        pg8::gemm_phase<pg8::EpiSwiGLU<false>, pg8::StaticOrder>(lds + RING_OFF, g, S, E, wave, lane);
        if (rep_ == 0) CVT_QUEUE(CW_Q1, CV_R0, CV_R1);
    }
    SEAM(1);
    if (IN(2)) for (int rep_ = 0; rep_ < NREP(2); ++rep_) {
        PH_IDS;
        pg8::Gemm g{ACT, WD1, M, D, FF, FF, FF, 0, 0}; pg8::StaticOrder S; S.init(M, D, G, bx);
        pg8::EpiBf16 E{HF, D, 1.0f};
        pg8::gemm_phase<pg8::EpiBf16, pg8::StaticOrder, false, 2>(lds + RING_OFF, g, S, E, wave, lane);
    }
    SEAM(2);
    if (IN(3)) for (int rep_ = 0; rep_ < NREP(3); ++rep_) {
        PH_IDS;
        LOAD_GAINS(args.in[5], args.in[6]);
#pragma unroll 1
        for (int m = gw; m < M; m += NGW) norm_row<true, false, 2, true>(HF + (size_t)m * D, XIN + (size_t)m * D, XRES + (size_t)m * D, XN + (size_t)m * D, 0.5f, gA, gB, lane);
        __syncthreads();
    }
    SEAM(3);
    if (IN(4)) for (int rep_ = 0; rep_ < NREP(4); ++rep_) {
        PH_IDS;
        pg8::Gemm g{XN, WIN, M, INW, D, D, D, 0, 0}; pg8::StaticOrder S; S.init(M, INW, G, bx);
        pg8::EpiInProj E{PROJ, INW, COS, SIN};
        pg8::gemm_phase<pg8::EpiInProj, pg8::StaticOrder, false, 0>(lds + RING_OFF, g, S, E, wave, lane);
        if (rep_ == 0) CVT_QUEUE(CW_Q2, CV_R1, CV_R2);
    }
    SEAM(4);
    if (IN(5)) for (int rep_ = 0; rep_ < NREP(5); ++rep_) {
        PH_IDS;
#pragma unroll 1
        for (int it = gw; it < 4 * (M / 16); it += NGW) { const int gq = it & 3, row0 = (it >> 2) * 16;
            if (gq == 0) pool_item2<2>(PROJ, YP, 0, row0, lane); else if (gq == 1) pool_item2<4>(PROJ, YP, 1, row0, lane);
            else if (gq == 2) pool_item2<8>(PROJ, YP, 2, row0, lane); else pool_item2<16>(PROJ, YP, 3, row0, lane); }
#pragma unroll 1
        for (int un = vcu; un < BATCH * NKV * (SEQ / 64); un += G) attn_unit(lds + RING_OFF, PROJ, MIX, args.in[8], un, tid, wave);
    }
    SEAM(5);
    if (IN(6)) for (int rep_ = 0; rep_ < NREP(6); ++rep_) {
        PH_IDS;
        pg8::Gemm g{YP, WPOOL, M, POOLW, PGW, POOLW, PGW, 1, PGW}; pg8::StaticOrder S; S.init(M, POOLW, G, bx);
        pg8::EpiPool E{MIX + ATTW, D, args.in[10]};
        pg8::gemm_phase<pg8::EpiPool, pg8::StaticOrder>(lds + RING_OFF, g, S, E, wave, lane);
    }
    SEAM(6);
    if (IN(7)) for (int rep_ = 0; rep_ < NREP(7); ++rep_) {
        PH_IDS;
        pg8::Gemm g{MIX, WOUT, M, D, D, D, D, 0, 0}; pg8::StaticOrder S; S.init(M, D, G, bx);
        pg8::EpiBf16 E{HF, D, 1.0f};
        pg8::gemm_phase<pg8::EpiBf16, pg8::StaticOrder, false, 2>(lds + RING_OFF, g, S, E, wave, lane);
    }
    SEAM(7);
    if (IN(8)) for (int rep_ = 0; rep_ < NREP(8); ++rep_) {
        PH_IDS;
        LOAD_GAINS(args.in[12], args.in[13]);
#pragma unroll 1
        for (int m = gw; m < M; m += NGW) norm_row<true, true, 2, true, P9_N8 / 2>(HF + (size_t)m * D, XRES + (size_t)m * D, XRES + (size_t)m * D, XN + (size_t)m * D, 1.0f, gA, gB, lane);
        __syncthreads();
    }
    SEAM(8);
    if (IN(9)) for (int rep_ = 0; rep_ < NREP(9); ++rep_) {
        PH_IDS;
        pg8::Gemm g{XN, WGU2, M, 2 * FF, D, D, D, 0, 0}; pg8::StaticOrder S; S.init(M, 2 * FF, G, bx);
        pg8::EpiSwiGLU<true> E{ACT, FF};
        pg8::gemm_phase<pg8::EpiSwiGLU<true>, pg8::StaticOrder, false, P9_PAD, P9_N8>(lds + RING_OFF, g, S, E, wave, lane);
        if (rep_ == 0) CVT_QUEUE(CW_Q3, CV_R2, CV_R3);
    }
    SEAM(9);
    if (IN(10)) for (int rep_ = 0; rep_ < NREP(10); ++rep_) {
        PH_IDS;
        pg8::Gemm g{ACT, WD2, M, D, FF / 2, FF / 2, FF / 2, 0, 0}; pg8::StaticOrder S; S.init(M, D, G, bx);
        pg8::EpiBf16 E{HF, D, 1.0f / 1024.0f};
        pg8::gemm_phase<pg8::EpiBf16, pg8::StaticOrder, true>(lds + RING_OFF, g, S, E, wave, lane);
    }
    SEAM(10);
    if (IN(11)) for (int rep_ = 0; rep_ < NREP(11); ++rep_) {
        PH_IDS;
        LOAD_GAINS(args.in[17], args.in[17]);
#pragma unroll 1
        for (int m = gw; m < M; m += NGW) norm_row<true, true, 1, false>(HF + (size_t)m * D, XRES + (size_t)m * D, OUTP + (size_t)m * D, nullptr, 0.5f, gA, gB, lane);
    }
#undef IN
#undef SEAM
#undef LOAD_GAINS
#undef CVT_QUEUE
#undef PH_IDS
}

extern "C" void kernel_launch(void* const* d_in, const int* in_sizes, int n_in, void* d_out, int out_size, void* d_ws, size_t ws_size, hipStream_t stream) {
    static int grid = 0;
    if (grid == 0) {
        if (n_in != 18 || in_sizes[0] != M * D || out_size != M * D || ws_size < WS_END) { fprintf(stderr, "kernel_launch: unexpected shapes (n_in %d, in0 %d, out %d, ws %zu, need %zu); nothing launched\n", n_in, n_in > 0 ? in_sizes[0] : -1, out_size, ws_size, (size_t)WS_END); grid = -1; return; }
        int dev = 0, cus = 0, per_cu = 0;
        if (hipGetDevice(&dev) != hipSuccess || hipDeviceGetAttribute(&cus, hipDeviceAttributeMultiprocessorCount, dev) != hipSuccess) { fprintf(stderr, "kernel_launch: device query failed\n"); grid = -1; return; }
        if (hipFuncSetAttribute((const void*)hymba_fwd, hipFuncAttributeMaxDynamicSharedMemorySize, LDS_BYTES) != hipSuccess) { fprintf(stderr, "kernel_launch: hipFuncSetAttribute failed\n"); grid = -1; return; }
        if (hipOccupancyMaxActiveBlocksPerMultiprocessor(&per_cu, (const void*)hymba_fwd, NWAVES * 64, LDS_BYTES) != hipSuccess || per_cu < 1)
            fprintf(stderr, "kernel_launch: note: occupancy query reports %d workgroups per CU\n", per_cu);
        (void)hipGetLastError();
        grid = cus;
    }
    if (grid < 0) return;
    if (hipMemsetAsync((char*)d_ws + WS_CTL, 0, CTL_ZERO_BYTES, stream) != hipSuccess) { fprintf(stderr, "kernel_launch: memset failed\n"); return; }
    Args a{};
    for (int i = 0; i < 18; ++i) a.in[i] = (const float*)d_in[i];
    a.out = (float*)d_out; a.ws = (unsigned char*)d_ws;
#if MK_SPLIT
    for (int p = 0; p < N_PHASES; ++p) { a.ph_lo = p; a.ph_hi = p + 1; hipLaunchKernelGGL(hymba_fwd, dim3(grid), dim3(NWAVES * 64), LDS_BYTES, stream, a); }
#else
    a.ph_lo = 0; a.ph_hi = N_PHASES;
    hipLaunchKernelGGL(hymba_fwd, dim3(grid), dim3(NWAVES * 64), LDS_BYTES, stream, a);
#endif
    const hipError_t le = hipPeekAtLastError();
    if (le != hipSuccess) fprintf(stderr, "kernel_launch: launch failed: %s\n", hipGetErrorName(le));
}
```

```cpp
#include <hip/hip_runtime.h>
#include <cstdio>
#include <cstdint>

#ifndef MK_SPLIT
#define MK_SPLIT 0
#endif

namespace pg8 {
#define PG8_LAS __attribute__((address_space(3)))
typedef unsigned short bf16_t;
typedef short bf16x8 __attribute__((ext_vector_type(8)));
typedef float f32x4 __attribute__((ext_vector_type(4)));
typedef unsigned u32x4 __attribute__((ext_vector_type(4)));
typedef int i32x8 __attribute__((ext_vector_type(8)));
constexpr int BM = 256, BK = 64, HALF = 128, HTB = HALF * BK * 2  , STAGE_BYTES = 8 * HTB, NXCD = 8, WGM = 8;

__host__ __device__ __forceinline__ int lds_byte(int r, int c) { return r * 128 + ((((c >> 3) ^ (r >> 1)) & 7) << 4) + (c & 7) * 2; }
__host__ __device__ __forceinline__ void stage_rc(int b, int& R, int& C) { R = b >> 7; C = ((((b >> 4) ^ (R >> 1)) & 7) << 3) + ((b & 15) >> 1); }
__host__ __device__ __forceinline__ int perm32(int rho) { const int n = rho >> 4, i = rho & 15; return 8 * (i >> 2) + 4 * n + (i & 3); }

struct Unit { int pm, pn; };
struct Gemm { const bf16_t* A; const bf16_t* Bt; int M, N, K, lda, ldb, a_shift, a_step; };

struct StaticOrder {
    int nM, nN, nwg, G, c;
    __host__ __device__ void init(int M, int N, int G_, int c_) { nM = M / BM; nN = N / BM; nwg = nM * nN; G = G_; c = c_; }
    __host__ __device__ bool next(int i, Unit& u) const {
        const long L = (long)i * G + c; if (L >= nwg) return false;
        int wgid = (int)L; { const int q = nwg / NXCD, r = nwg % NXCD, xcd = wgid % NXCD, off = wgid / NXCD; wgid = (xcd < r ? xcd * (q + 1) : r * (q + 1) + (xcd - r) * q) + off; }
        const int nig = WGM * nN, gid = wgid / nig, fm = gid * WGM, gsz = (nM - fm) < WGM ? (nM - fm) : WGM;
        u.pm = fm + ((wgid % nig) % gsz); u.pn = (wgid % nig) / gsz; return true;
    }
    __device__ __forceinline__ void a_ready(const Unit&) const {}
    __device__ __forceinline__ void done(const Unit&) const {}
};

__device__ __forceinline__ unsigned cvt_pk_bf16(float lo, float hi) { unsigned r; asm volatile("v_cvt_pk_bf16_f32 %0, %1, %2" : "=v"(r) : "v"(lo), "v"(hi)); return r; }
__device__ __forceinline__ u32x4 pack8(const f32x4 a, const f32x4 b) { u32x4 w; w.x = cvt_pk_bf16(a[0], a[1]); w.y = cvt_pk_bf16(a[2], a[3]); w.z = cvt_pk_bf16(b[0], b[1]); w.w = cvt_pk_bf16(b[2], b[3]); return w; }

struct EpiF32 {
    static constexpr bool PERM = false;
    float* C; int ldc;
    __device__ __forceinline__ void operator()(const f32x4 (&acc)[2][2][4][2], const Unit& u, int wr, int wc, int fr, int fq) const {
        const int row0 = u.pm * BM + wr * 64 + fr, col0 = u.pn * BM + wc * 32 + 4 * fq;
#pragma unroll
        for (int ai = 0; ai < 2; ++ai)
#pragma unroll
            for (int m = 0; m < 4; ++m) { float* rowp = C + (size_t)(row0 + ai * HALF + m * 16) * ldc + col0;
#pragma unroll
                for (int bj = 0; bj < 2; ++bj)
#pragma unroll
                    for (int n = 0; n < 2; ++n) *(f32x4*)(rowp + bj * HALF + n * 16) = acc[ai][bj][m][n]; }
    }
};
__device__ __forceinline__ unsigned cvt4_fp8(float a, float b, float c, float d) {
    a = __builtin_amdgcn_fmed3f(a, -448.f, 448.f); b = __builtin_amdgcn_fmed3f(b, -448.f, 448.f); c = __builtin_amdgcn_fmed3f(c, -448.f, 448.f); d = __builtin_amdgcn_fmed3f(d, -448.f, 448.f);
    unsigned w = 0u; w = __builtin_amdgcn_cvt_pk_fp8_f32(a, b, w, false); w = __builtin_amdgcn_cvt_pk_fp8_f32(c, d, w, true); return w;
}
struct EpiBf16 {
    static constexpr bool PERM = true;
    bf16_t* O; int ldc; float scale;
    __device__ __forceinline__ void operator()(const f32x4 (&acc)[2][2][4][2], const Unit& u, int wr, int wc, int fr, int fq) const {
        const int row0 = u.pm * BM + wr * 64 + fr, col0 = u.pn * BM + wc * 32 + 8 * fq;
#pragma unroll
        for (int ai = 0; ai < 2; ++ai)
#pragma unroll
            for (int m = 0; m < 4; ++m) { bf16_t* rowp = O + (size_t)(row0 + ai * HALF + m * 16) * ldc + col0;
#pragma unroll
                for (int bj = 0; bj < 2; ++bj) *(u32x4*)(rowp + bj * HALF) = pack8(acc[ai][bj][m][0] * scale, acc[ai][bj][m][1] * scale); }
    }
};
__device__ __forceinline__ float silu_f(float x) { return x * __builtin_amdgcn_rcpf(1.0f + __builtin_amdgcn_exp2f(-1.44269504089f * x)); }
template <bool F8OUT>
struct EpiSwiGLU {
    static constexpr bool PERM = true;
    bf16_t* O; int ldc;
    __device__ __forceinline__ void operator()(const f32x4 (&acc)[2][2][4][2], const Unit& u, int wr, int wc, int fr, int fq) const {
        const int row0 = u.pm * BM + wr * 64 + fr, col0 = u.pn * HALF + wc * 32 + 8 * fq;
#pragma unroll
        for (int ai = 0; ai < 2; ++ai)
#pragma unroll
            for (int m = 0; m < 4; ++m) { bf16_t* rowp = O + (size_t)(row0 + ai * HALF + m * 16) * ldc + col0;
                f32x4 v0, v1;
#pragma unroll
                for (int e = 0; e < 4; ++e) { v0[e] = silu_f(acc[ai][0][m][0][e]) * acc[ai][1][m][0][e]; v1[e] = silu_f(acc[ai][0][m][1][e]) * acc[ai][1][m][1][e]; }
                if (F8OUT) { typedef unsigned u32x2v __attribute__((ext_vector_type(2))); v0 = v0 * 16.0f; v1 = v1 * 16.0f;
                    unsigned char* bp = (unsigned char*)O + (size_t)(row0 + ai * HALF + m * 16) * ldc + col0;
                    u32x2v w; w.x = cvt4_fp8(v0[0], v0[1], v0[2], v0[3]); w.y = cvt4_fp8(v1[0], v1[1], v1[2], v1[3]); *(u32x2v*)bp = w; }
                else *(u32x4*)rowp = pack8(v0, v1); }
    }
};
struct EpiInProj {
    static constexpr bool PERM = true;
    bf16_t* O; int ldc; const float* cs; const float* sn;
    __device__ __forceinline__ void operator()(const f32x4 (&acc)[2][2][4][2], const Unit& u, int wr, int wc, int fr, int fq) const {
        const int row0 = u.pm * BM + wr * 64 + fr;
        if (u.pn < 10) {
            const int hsel = wc >> 1, ii0 = 32 * (wc & 1) + 8 * fq, col0 = u.pn * BM + 128 * hsel + ii0;
            const float* cp = cs + ii0; const float* sp = sn + ii0;
            f32x4 tc0[2], tc1[2], ts0[2], ts1[2];
            { const int pos = row0 & 2047; tc0[0] = *(const f32x4*)(cp + pos * 64); tc1[0] = *(const f32x4*)(cp + pos * 64 + 4); ts0[0] = *(const f32x4*)(sp + pos * 64); ts1[0] = *(const f32x4*)(sp + pos * 64 + 4); }
#pragma unroll
            for (int it = 0; it < 8; ++it) { const int ai = it >> 2, m = it & 3, sl = it & 1, row = row0 + ai * HALF + m * 16; bf16_t* rowp = O + (size_t)row * ldc + col0;
                if (it + 1 < 8) { const int pos = (row0 + ((it + 1) >> 2) * HALF + ((it + 1) & 3) * 16) & 2047, ns = sl ^ 1;
                    tc0[ns] = *(const f32x4*)(cp + pos * 64); tc1[ns] = *(const f32x4*)(cp + pos * 64 + 4); ts0[ns] = *(const f32x4*)(sp + pos * 64); ts1[ns] = *(const f32x4*)(sp + pos * 64 + 4); }
                const f32x4 c0 = tc0[sl], c1 = tc1[sl], s0 = ts0[sl], s1 = ts1[sl];
                const f32x4 a0 = acc[ai][0][m][0], a1 = acc[ai][0][m][1], b0 = acc[ai][1][m][0], b1 = acc[ai][1][m][1];
                *(u32x4*)rowp = pack8(a0 * c0 - b0 * s0, a1 * c1 - b1 * s1);
                *(u32x4*)(rowp + 64) = pack8(b0 * c0 + a0 * s0, b1 * c1 + a1 * s1); }
        } else {
            const int col0 = u.pn * BM + wc * 32 + 8 * fq;
#pragma unroll
            for (int ai = 0; ai < 2; ++ai)
#pragma unroll
                for (int m = 0; m < 4; ++m) { bf16_t* rowp = O + (size_t)(row0 + ai * HALF + m * 16) * ldc + col0;
#pragma unroll
                    for (int bj = 0; bj < 2; ++bj) *(u32x4*)(rowp + bj * HALF) = pack8(acc[ai][bj][m][0], acc[ai][bj][m][1]); }
        }
    }
};
struct EpiPool {
    static constexpr bool PERM = true;
    bf16_t* O; int ldc; const float* scale;
    __device__ __forceinline__ void operator()(const f32x4 (&acc)[2][2][4][2], const Unit& u, int wr, int wc, int fr, int fq) const {
        const int row0 = u.pm * BM + wr * 64 + fr, col0 = u.pn * BM + wc * 32 + 8 * fq;
        f32x4 sv[2][2];
#pragma unroll
        for (int bj = 0; bj < 2; ++bj) { sv[bj][0] = *(const f32x4*)(scale + col0 + bj * HALF); sv[bj][1] = *(const f32x4*)(scale + col0 + bj * HALF + 4); }
#pragma unroll
        for (int ai = 0; ai < 2; ++ai)
#pragma unroll
            for (int m = 0; m < 4; ++m) { bf16_t* rowp = O + (size_t)(row0 + ai * HALF + m * 16) * ldc + col0;
#pragma unroll
                for (int bj = 0; bj < 2; ++bj) *(u32x4*)(rowp + bj * HALF) = pack8(acc[ai][bj][m][0] * sv[bj][0], acc[ai][bj][m][1] * sv[bj][1]); }
    }
};

template <class Epi, class Sched, bool F8 = false, int PADV = 0, int N8 = 0>
__device__ __forceinline__ void gemm_phase(PG8_LAS unsigned char* lds, const Gemm g, const Sched& S, const Epi& E, const int wid, const int lane) {
    const int tid = wid * 64 + lane, wr = wid >> 2, wc = wid & 3, fr = lane & 15, fq = lane >> 4;
    const int K = g.K, nt = K / BK - N8;
    unsigned voffA[2], voffB[2];
#pragma unroll
    for (int i = 0; i < 2; ++i) { int R, C; stage_rc(tid * 16 + i * 8192, R, C); const int Rb = Epi::PERM ? ((R & ~31) + perm32(R & 31)) : R;
        voffA[i] = (unsigned)(R * g.lda + C) * 2u; voffB[i] = (unsigned)(Rb * g.ldb + C) * 2u; }
    const size_t kstep = (size_t)(BK * 2);
    const size_t hstepA = (size_t)HALF * g.lda * 2, hstepB = (size_t)HALF * g.ldb * 2;
    const size_t tstepA = 2 * hstepA, tstepB = 2 * hstepB;
    const unsigned ldsw = (unsigned)wid * 1024u;
    const unsigned ldsu = (unsigned)(unsigned long long)lds + ldsw;
    unsigned pa0 = (unsigned)(unsigned long long)lds + (unsigned)lds_byte(wr * 64 + fr, fq * 8), pb0 = (unsigned)(unsigned long long)lds + 4u * HTB + (unsigned)lds_byte(wc * 32 + fr, fq * 8);
    unsigned pa1 = pa0 ^ 64u, pb1 = pb0 ^ 64u;
    asm volatile("" : "+v"(pa0), "+v"(pa1), "+v"(pb0), "+v"(pb1));
#define PG8_SA(b, h) (((b) * 2 + (h)) * HTB)
#define PG8_SB(b, h) ((4 + (b) * 2 + (h)) * HTB)
#define PG8_STAGE(bufoff, gbase, voff) do { _Pragma("unroll") for (int _i = 0; _i < 2; ++_i) \
        asm volatile("s_mov_b32 m0, %2\n\ts_nop 0\n\tglobal_load_lds_dwordx4 %0, %1" :: "v"((voff)[_i]), "s"((unsigned long long)(gbase)), "s"(ldsu + (unsigned)((bufoff) + _i * 8192)) : "memory"); } while (0)
#define PG8_LDA(dst, b, h) do { _Pragma("unroll") for (int m = 0; m < 4; ++m) _Pragma("unroll") for (int k = 0; k < 2; ++k) dst[m][k] = *(const PG8_LAS bf16x8*)(unsigned long long)((k ? pa1 : pa0) + (unsigned)(PG8_SA(b, h) + m * 2048)); } while (0)
#define PG8_LDB(dst, b, h) do { _Pragma("unroll") for (int n = 0; n < 2; ++n) _Pragma("unroll") for (int k = 0; k < 2; ++k) dst[n][k] = *(const PG8_LAS bf16x8*)(unsigned long long)((k ? pb1 : pb0) + (unsigned)(PG8_SB(b, h) - 4 * HTB + n * 2048)); } while (0)
#define PG8_CAT8(lo, hi) (i32x8){(int)__builtin_bit_cast(u32x4, lo).x, (int)__builtin_bit_cast(u32x4, lo).y, (int)__builtin_bit_cast(u32x4, lo).z, (int)__builtin_bit_cast(u32x4, lo).w, \
        (int)__builtin_bit_cast(u32x4, hi).x, (int)__builtin_bit_cast(u32x4, hi).y, (int)__builtin_bit_cast(u32x4, hi).z, (int)__builtin_bit_cast(u32x4, hi).w}
#define PG8_MMA(F8X, ai, bj, At, Bt) do { __builtin_amdgcn_s_setprio(1); \
        if constexpr (F8X) { _Pragma("unroll") for (int m = 0; m < 4; ++m) _Pragma("unroll") for (int n = 0; n < 2; ++n) \
            acc[ai][bj][m][n] = __builtin_amdgcn_mfma_scale_f32_16x16x128_f8f6f4(PG8_CAT8(Bt[n][0], Bt[n][1]), PG8_CAT8(At[m][0], At[m][1]), acc[ai][bj][m][n], 0, 0, 0, 0x7f7f7f7f, 0, 0x7f7f7f7f); } \
        else { _Pragma("unroll") for (int m = 0; m < 4; ++m) _Pragma("unroll") for (int n = 0; n < 2; ++n) _Pragma("unroll") for (int k = 0; k < 2; ++k) \
            acc[ai][bj][m][n] = __builtin_amdgcn_mfma_f32_16x16x32_bf16(Bt[n][k], At[m][k], acc[ai][bj][m][n], 0, 0, 0); } \
        __builtin_amdgcn_s_setprio(0); } while (0)
#ifndef PG8_ALIGN_LOOP
#define PG8_ALIGN_LOOP asm volatile(".p2align 8" ::: "memory")
#endif
#define PG8_WAIT_V(n) asm volatile("s_waitcnt vmcnt(" #n ")" ::: "memory")
#define PG8_WAIT_L(n) asm volatile("s_waitcnt lgkmcnt(" #n ")" ::: "memory")
#define PG8_BAR __builtin_amdgcn_s_barrier()
#define PG8_SCHED __builtin_amdgcn_sched_barrier(0)
#define PG8_TOFF(t) ((size_t)((t) + ((N8 > 0 && (t) >= N8) ? N8 : 0)) * kstep)
#define PG8_KLOOP(T0, T1, F8X, LASTOK) \
        PG8_ALIGN_LOOP; \
        for (int t = (T0); t < (T1); t += 2) { \
            const bool last = (LASTOK) && (t == nt - 2); \
            const char* a1 = cA + PG8_TOFF(t + 1); \
            const char* a2 = last ? nA : cA + PG8_TOFF(t + 2); const char* b2 = last ? nB : cB + PG8_TOFF(t + 2); \
            const char* b3 = last ? nB + kstep : cB + PG8_TOFF(t + 3); \
            if (last && has_next) S.a_ready(nxt); \
              \
              \
            PG8_LDB(B0, 0, 0); PG8_LDB(B1, 0, 1); PG8_SCHED; PG8_LDA(At, 0, 0); PG8_STAGE(PG8_SA(1, 0), a1, voffA); PG8_STAGE(PG8_SA(1, 1), a1 + hstepA, voffA); \
            PG8_WAIT_V(8); PG8_WAIT_L(0); PG8_BAR; PG8_MMA(F8X, 0, 0, At, B0); PG8_MMA(F8X, 0, 1, At, B1); PG8_BAR; PG8_SCHED; \
              \
            PG8_LDA(At, 0, 1); PG8_STAGE(PG8_SB(0, 0), b2, voffB); PG8_STAGE(PG8_SB(0, 1), b2 + hstepB, voffB); \
            PG8_WAIT_V(6); PG8_WAIT_L(0); PG8_BAR; PG8_MMA(F8X, 1, 0, At, B0); PG8_MMA(F8X, 1, 1, At, B1); PG8_BAR; PG8_SCHED; \
              \
            PG8_LDB(B0, 1, 0); PG8_LDB(B1, 1, 1); PG8_SCHED; PG8_LDA(At, 1, 0); PG8_STAGE(PG8_SA(0, 0), a2, voffA); PG8_STAGE(PG8_SA(0, 1), a2 + hstepA, voffA); \
            PG8_WAIT_V(8); PG8_WAIT_L(0); PG8_BAR; PG8_MMA(F8X, 0, 0, At, B0); PG8_MMA(F8X, 0, 1, At, B1); PG8_BAR; PG8_SCHED; \
              \
            PG8_LDA(At, 1, 1); PG8_STAGE(PG8_SB(1, 0), b3, voffB); PG8_STAGE(PG8_SB(1, 1), b3 + hstepB, voffB); \
            PG8_WAIT_V(6); PG8_WAIT_L(0); PG8_BAR; PG8_MMA(F8X, 1, 0, At, B0); PG8_MMA(F8X, 1, 1, At, B1); PG8_BAR; PG8_SCHED; \
        }
    Unit cur, nxt; int ui = 0;
    if (!S.next(0, cur)) return;
    int padv[PADV ? PADV : 1];
    if constexpr (PADV > 0) { _Pragma("unroll") for (int i = 0; i < PADV; ++i) asm volatile("v_mov_b32 %0, 0" : "=v"(padv[i])); }
    f32x4 acc[2][2][4][2];
#pragma unroll
    for (int a = 0; a < 2; ++a)
#pragma unroll
        for (int b = 0; b < 2; ++b)
#pragma unroll
            for (int m = 0; m < 4; ++m)
#pragma unroll
                for (int n = 0; n < 2; ++n) acc[a][b][m][n] = (f32x4){0.f, 0.f, 0.f, 0.f};
    bf16x8 At[4][2], B0[2][2], B1[2][2];
    const char* cA = (const char*)g.A + (size_t)cur.pm * tstepA + (size_t)((cur.pn >> g.a_shift) * g.a_step) * 2; const char* cB = (const char*)g.Bt + (size_t)cur.pn * tstepB;
    S.a_ready(cur);
    PG8_STAGE(PG8_SB(0, 0), cB, voffB); PG8_STAGE(PG8_SB(0, 1), cB + hstepB, voffB); PG8_STAGE(PG8_SA(0, 0), cA, voffA); PG8_STAGE(PG8_SA(0, 1), cA + hstepA, voffA);
    if (wr == 1) PG8_BAR;
    PG8_WAIT_V(2); PG8_BAR;
    PG8_STAGE(PG8_SB(1, 0), cB + kstep, voffB); PG8_STAGE(PG8_SB(1, 1), cB + hstepB + kstep, voffB);
    PG8_WAIT_V(4); PG8_BAR;
    for (;;) {
        const bool has_next = S.next(ui + 1, nxt);
        const char* nA = has_next ? (const char*)g.A + (size_t)nxt.pm * tstepA + (size_t)((nxt.pn >> g.a_shift) * g.a_step) * 2 : cA; const char* nB = has_next ? (const char*)g.Bt + (size_t)nxt.pn * tstepB : cB;
        if constexpr (N8 > 0) {
            PG8_KLOOP(0, N8, true, false)
#pragma unroll
            for (int a = 0; a < 2; ++a)
#pragma unroll
                for (int b = 0; b < 2; ++b)
#pragma unroll
                    for (int m = 0; m < 4; ++m)
#pragma unroll
                        for (int n = 0; n < 2; ++n) acc[a][b][m][n] = acc[a][b][m][n] * (1.0f / 1024.0f);
            PG8_KLOOP(N8, nt, false, true)
        } else { PG8_KLOOP(0, nt, F8, true) }
        if (wr == 0) PG8_BAR;
        E(acc, cur, wr, wc, fr, fq); S.done(cur);
        if (!has_next) break;
#pragma unroll
        for (int a = 0; a < 2; ++a)
#pragma unroll
            for (int b = 0; b < 2; ++b)
#pragma unroll
                for (int m = 0; m < 4; ++m)
#pragma unroll
                    for (int n = 0; n < 2; ++n) acc[a][b][m][n] = (f32x4){0.f, 0.f, 0.f, 0.f};
        cur = nxt; cA = nA; cB = nB; ++ui;
        if (wr == 1) PG8_BAR;
    }
    PG8_WAIT_V(0);
    PG8_BAR;
    if constexpr (PADV > 0) { _Pragma("unroll") for (int i = 0; i < PADV; ++i) asm volatile("" :: "v"(padv[i])); }
#undef PG8_SA
#undef PG8_SB
#undef PG8_STAGE
#undef PG8_LDA
#undef PG8_LDB
#undef PG8_MMA
#undef PG8_KLOOP
#undef PG8_TOFF
#undef PG8_CAT8
#undef PG8_WAIT_V
#undef PG8_WAIT_L
#undef PG8_BAR
#undef PG8_SCHED
}
}

constexpr int NWAVES = 8;
constexpr int BATCH = 4, SEQ = 2048, D = 4096, M = BATCH * SEQ;
constexpr int HD = 128, NH = 16, NKV = 4, ATTW = 2048, KVW = 512, POOLW = 2048, PGW = 512, INW = 5120, FF = 11008;
constexpr float RMS_EPS = 1e-6f;
constexpr int N_PHASES = 12;
constexpr int P9_N8 = 2, P9_PAD = 2;

constexpr size_t MiB = 1u << 20;
constexpr size_t WS_CTL = 0, CTL_ZERO_BYTES = 1 * MiB;
constexpr size_t WS_COS = 1 * MiB, WS_SIN = WS_COS + 512 * 1024;
constexpr size_t WS_WGU1 = 2 * MiB;
constexpr size_t WS_WD1 = WS_WGU1 + 172 * MiB;
constexpr size_t WS_WIN = WS_WD1 + 86 * MiB;
constexpr size_t WS_WOUT = WS_WIN + 40 * MiB;
constexpr size_t WS_WPOOL = WS_WOUT + 32 * MiB;
constexpr size_t WS_WGU2 = WS_WPOOL + 2 * MiB;
constexpr size_t WS_WD2 = WS_WGU2 + 172 * MiB;
constexpr size_t WS_XN = WS_WD2 + 86 * MiB;
constexpr size_t WS_ACT = WS_XN + 64 * MiB;
constexpr size_t WS_HF = WS_ACT + 172 * MiB;
constexpr size_t WS_PROJ = WS_HF + 128 * MiB;
constexpr size_t WS_MIX = WS_PROJ + 80 * MiB;
constexpr size_t WS_YP = WS_MIX + 64 * MiB;
constexpr size_t WS_END = WS_YP + 32 * MiB;
static_assert((size_t)2 * FF * D * 2 == 172 * MiB && (size_t)D * FF * 2 == 86 * MiB && (size_t)M * FF * 2 == 172 * MiB, "sizes");
constexpr int CW_BAR = 4096;

constexpr int RING_OFF = 0, RING_BYTES = 131072;
constexpr int LDSCTL_OFF = RING_BYTES, MISC_OFF = LDSCTL_OFF + 320;
constexpr int LDS_BYTES = 147456;
constexpr int GAIN_OFF = 98304;
static_assert(MISC_OFF + 128 <= LDS_BYTES, "LDS map");

#define GAS __attribute__((address_space(1)))
#define LAS __attribute__((address_space(3)))
typedef unsigned short bf16;
typedef unsigned v4u __attribute__((ext_vector_type(4)));
typedef unsigned v2u __attribute__((ext_vector_type(2)));
typedef float f32x4 __attribute__((ext_vector_type(4)));
typedef float f32x16 __attribute__((ext_vector_type(16)));
typedef short bf16x8 __attribute__((ext_vector_type(8)));
typedef GAS unsigned gu32;
#define RLX_AGENT __ATOMIC_RELAXED, __HIP_MEMORY_SCOPE_AGENT
#define LDS_WAIT() asm volatile("s_waitcnt lgkmcnt(0)" ::: "memory")
#define VM_WAIT() asm volatile("s_waitcnt vmcnt(0)" ::: "memory")
__device__ __forceinline__ unsigned f2bf(float f) { unsigned u = __builtin_bit_cast(unsigned, f); return (u + 0x7fffu + ((u >> 16) & 1u)) >> 16; }
__device__ __forceinline__ unsigned pk2(float lo, float hi) { return f2bf(lo) | (f2bf(hi) << 16); }
__device__ __forceinline__ float bf_lo(unsigned w) { return __builtin_bit_cast(float, w << 16); }
__device__ __forceinline__ float bf_hi(unsigned w) { return __builtin_bit_cast(float, w & 0xffff0000u); }

#define XB_TMO      128
#define XB_XCNT(j)  (256  + 64 * (j))
#define XB_XSUB(j)  (1280 + 64 * (j))
#define XB_XGEN(j)  (2304 + 64 * (j))
#define XB_TOP      3328
#define XB_TOPGEN   3392
#define XCD_BAR_WORDS 3456
#define XB_SPIN_CAP (1u << 18)

__device__ __forceinline__ unsigned xb_ld(unsigned* p)              { return __hip_atomic_load(p, __ATOMIC_RELAXED, __HIP_MEMORY_SCOPE_AGENT); }
__device__ __forceinline__ unsigned xb_add(unsigned* p, unsigned v) { return __hip_atomic_fetch_add(p, v, __ATOMIC_RELAXED, __HIP_MEMORY_SCOPE_AGENT); }
__device__ __forceinline__ unsigned xb_xcc_id() { return (unsigned)__builtin_amdgcn_s_getreg((3 << 11) | 20) & 0xFu; }
#define XB_SPIN(cond, bar) do { unsigned _sp = 0; while (cond) { __builtin_amdgcn_s_sleep(1); \
    if ((++_sp & 255u) == 0u) { if (xb_ld(&(bar)[XB_TMO])) break; if (_sp > XB_SPIN_CAP) { atomicAdd(&(bar)[XB_TMO], 1u); break; } } } } while (0)

struct XcdBarrier {
    unsigned* bar; unsigned x;
    volatile LAS unsigned* st;
};
__device__ __forceinline__ XcdBarrier xcd_barrier_post(unsigned* bar, volatile LAS unsigned* st) {
    XcdBarrier b; b.bar = bar; b.x = xb_xcc_id(); b.st = st;
    if (threadIdx.x == 0) (void)xb_add(&bar[XB_XCNT(b.x)], 1u);
    return b;
}
__device__ __forceinline__ void xcd_barrier_complete(unsigned* bar, unsigned x, unsigned& nloc, unsigned& nx) {
    const unsigned G = gridDim.x * gridDim.y * gridDim.z;
    unsigned sum, cnt, mine, sp = 0u;
    for (;;) {
        sum = 0u; cnt = 0u; mine = 0u;
#pragma unroll
        for (unsigned j = 0; j < 16; ++j) { const unsigned c = xb_ld(&bar[XB_XCNT(j)]); sum += c; cnt += (c > 0u) ? 1u : 0u; mine = (j == x) ? c : mine; }
        if (sum == G) break;
        __builtin_amdgcn_s_sleep(1);
        if ((++sp & 255u) == 0u) { if (xb_ld(&bar[XB_TMO])) break; if (sp > XB_SPIN_CAP) { atomicAdd(&bar[XB_TMO], 1u); break; } }
    }
    nloc = mine > 0u ? mine : 1u; nx = cnt > 0u ? cnt : 1u;
}
__device__ __forceinline__ void xcd_barrier(const XcdBarrier& b) {
    asm volatile("s_waitcnt vmcnt(0)" ::: "memory");
    __syncthreads();
    if (threadIdx.x == 0) {
        unsigned* bar = b.bar;
        __builtin_amdgcn_s_waitcnt(0);
        unsigned nloc = b.st[0], nx = b.st[1];
        if (nloc == 0u) { xcd_barrier_complete(bar, b.x, nloc, nx); b.st[0] = nloc; b.st[1] = nx; }
        const unsigned old = xb_add(&bar[XB_XSUB(b.x)], 1u);
        const unsigned gen = old / nloc;
        if (old + 1u == (gen + 1u) * nloc) {
            __builtin_amdgcn_fence(__ATOMIC_RELEASE, "agent");
            asm volatile("s_waitcnt vmcnt(0)" ::: "memory");
            const unsigned og = xb_add(&bar[XB_TOP], 1u);
            const unsigned tg = og / nx;
            if (og + 1u == (tg + 1u) * nx) xb_add(&bar[XB_TOPGEN], 1u);
            else XB_SPIN(xb_ld(&bar[XB_TOPGEN]) == tg, bar);
            __builtin_amdgcn_fence(__ATOMIC_ACQUIRE, "agent");
            xb_add(&bar[XB_XGEN(b.x)], 1u);
            asm volatile("s_waitcnt vmcnt(0)" ::: "memory");
        } else {
            XB_SPIN(xb_ld(&bar[XB_XGEN(b.x)]) == gen, bar);
            __builtin_amdgcn_fence(__ATOMIC_ACQUIRE, "agent");
            asm volatile("s_waitcnt vmcnt(0)" ::: "memory");
        }
    }
    __syncthreads();
}

__device__ __forceinline__ int lane_id_v() { int l; asm volatile("v_mbcnt_lo_u32_b32 %0, -1, 0\n\tv_mbcnt_hi_u32_b32 %0, -1, %0" : "=v"(l)); return l; }
__device__ __forceinline__ float wave_sum(float v) {
#define WS_DPP(ctrl, rmask) v += __builtin_bit_cast(float, __builtin_amdgcn_update_dpp(0, __builtin_bit_cast(int, v), (ctrl), (rmask), 0xf, true))
    WS_DPP(0x111, 0xf); WS_DPP(0x112, 0xf); WS_DPP(0x114, 0xf); WS_DPP(0x118, 0xf);
    WS_DPP(0x142, 0xa);
    WS_DPP(0x143, 0xc);
#undef WS_DPP
    return __builtin_bit_cast(float, __builtin_amdgcn_readlane(__builtin_bit_cast(int, v), 63));
}
__device__ __forceinline__ void cvt_item(const float* W, int N, int k0, int n0, bf16* WT, int ldk, int drow0, LAS float* scr, int lane, int f8 = 0  ) {
    float v[32];
    const GAS float* src = (const GAS float*)W + (size_t)(k0 + (lane >> 5)) * N + n0 + (lane & 31);
#pragma unroll
    for (int i = 0; i < 32; ++i) v[i] = __builtin_nontemporal_load(src + (size_t)(2 * i) * N);
#pragma unroll
    for (int i = 0; i < 32; ++i) scr[(2 * i + (lane >> 5)) * 33 + (lane & 31)] = v[i];
    LDS_WAIT(); asm volatile("" ::: "memory");
    const int c = lane & 7;
#pragma unroll
    for (int j = 0; j < 4; ++j) { const int n = (lane >> 3) + 8 * j; const LAS float* s = scr + (8 * c) * 33 + n;
        const size_t eo = (size_t)(drow0 + n) * ldk + k0 + 8 * c;
        if (f8) { typedef unsigned v2u __attribute__((ext_vector_type(2))); v2u o; o.x = pg8::cvt4_fp8(64.f * s[0 * 33], 64.f * s[1 * 33], 64.f * s[2 * 33], 64.f * s[3 * 33]); o.y = pg8::cvt4_fp8(64.f * s[4 * 33], 64.f * s[5 * 33], 64.f * s[6 * 33], 64.f * s[7 * 33]);
            *(GAS v2u*)((GAS unsigned char*)WT + (size_t)(drow0 + n) * f8 + k0 + 8 * c) = o; }
        else { v4u o; o.x = pk2(s[0 * 33], s[1 * 33]); o.y = pk2(s[2 * 33], s[3 * 33]); o.z = pk2(s[4 * 33], s[5 * 33]); o.w = pk2(s[6 * 33], s[7 * 33]);
            *(GAS v4u*)(WT + eo) = o; } }
    LDS_WAIT(); asm volatile("" ::: "memory");
}
__device__ __forceinline__ int drow_gu(int n0, int up) { return 256 * (n0 >> 7) + 128 * up + (n0 & 127); }
__device__ __forceinline__ int drow_in(int n0) { if (n0 >= 2560) return n0; const int pn = n0 >> 8, rem = n0 & 255, hsel = rem >> 7, r2 = rem & 127, bj = r2 >> 6, ii = r2 & 63; return 256 * pn + 128 * bj + 64 * hsel + ii; }

typedef __amdgpu_buffer_rsrc_t rsrc_t;
__device__ __forceinline__ rsrc_t mk_rsrc(const void* p) { return __builtin_amdgcn_make_buffer_rsrc((void*)p, 0, 0x7fffffff, 0x00020000); }
constexpr int BUF_NT = 2;
template <bool HAS_H, int XIN, int WRITE_X  , bool WRITE_XN, int XN_F8J = 0  >
__device__ __forceinline__ void norm_row(rsrc_t rh, int oh, rsrc_t rx, int ox, rsrc_t ro, int oo, rsrc_t rn, int on, float w, const LAS float* gpost, const LAS float* gpre, int lane,
                                         const LAS float* ginv = nullptr, float xscale = 0.f, float* rs_out = nullptr) {
    asm volatile("" ::: "memory");
    const int v8 = lane * 8, v16 = lane * 16;
    f32x4 xv[16];
    if (XIN != 0) {
#pragma unroll
        for (int j = 0; j < 16; ++j) { const v2u q = __builtin_amdgcn_raw_buffer_load_b64(rx, v8, ox + 512 * j, BUF_NT); xv[j] = (f32x4){bf_lo(q.x), bf_hi(q.x), bf_lo(q.y), bf_hi(q.y)}; }
    } else {
#pragma unroll
        for (int j = 0; j < 16; ++j) xv[j] = __builtin_bit_cast(f32x4, __builtin_amdgcn_raw_buffer_load_b128(rx, v16, ox + 1024 * j, BUF_NT)); }
    if (HAS_H) {
        f32x4 hv[16]; float s = 0.f;
#pragma unroll
        for (int j = 0; j < 16; ++j) { const v2u q = __builtin_amdgcn_raw_buffer_load_b64(rh, v8, oh + 512 * j, BUF_NT); hv[j] = (f32x4){bf_lo(q.x), bf_hi(q.x), bf_lo(q.y), bf_hi(q.y)}; }
#pragma unroll
        for (int j = 0; j < 16; ++j) s += (hv[j].x * hv[j].x + hv[j].y * hv[j].y) + (hv[j].z * hv[j].z + hv[j].w * hv[j].w);
        const float rstd = w / sqrtf(wave_sum(s) * (1.f / D) + RMS_EPS);
        asm volatile("" ::: "memory");
#pragma unroll
        for (int j = 0; j < 16; ++j) { const f32x4 gg = *(const LAS f32x4*)(gpost + 4 * lane + 256 * j);
            if (XIN == 2) { const f32x4 gi = *(const LAS f32x4*)(ginv + 4 * lane + 256 * j); xv[j] = xv[j] * (gi * xscale) + hv[j] * rstd * gg; }
            else xv[j] = xv[j] + hv[j] * rstd * gg; }
        if (WRITE_X == 1) {
#pragma unroll
            for (int j = 0; j < 16; ++j) __builtin_amdgcn_raw_buffer_store_b128(__builtin_bit_cast(v4u, xv[j]), ro, v16, oo + 1024 * j, BUF_NT); }
        if (WRITE_X == 2) {
#pragma unroll
            for (int j = 0; j < 16; ++j) { v2u pk; pk.x = pk2(xv[j].x, xv[j].y); pk.y = pk2(xv[j].z, xv[j].w); __builtin_amdgcn_raw_buffer_store_b64(pk, ro, v8, oo + 512 * j, BUF_NT); } }
    }
    if (WRITE_XN) {
        float s2 = 0.f;
#pragma unroll
        for (int j = 0; j < 16; ++j) s2 += (xv[j].x * xv[j].x + xv[j].y * xv[j].y) + (xv[j].z * xv[j].z + xv[j].w * xv[j].w);
        const float rms2 = sqrtf(wave_sum(s2) * (1.f / D) + RMS_EPS), rstd2 = 1.f / rms2;
        if (rs_out != nullptr && lane == 0) *rs_out = rms2;
        asm volatile("" ::: "memory");
#pragma unroll
        for (int j = 0; j < 16; ++j) { const f32x4 gg = *(const LAS f32x4*)(gpre + 4 * lane + 256 * j); const f32x4 o = xv[j] * rstd2 * gg;
            if (j < XN_F8J) __builtin_amdgcn_raw_buffer_store_b32(pg8::cvt4_fp8(16.f * o.x, 16.f * o.y, 16.f * o.z, 16.f * o.w), rn, lane * 4, on + 256 * j, 0);
            else { v2u pk; pk.x = pk2(o.x, o.y); pk.y = pk2(o.z, o.w); __builtin_amdgcn_raw_buffer_store_b64(pk, rn, v8, on + 512 * j, 0); } }
    }
}
template <int W, bool FIRST>
__device__ __forceinline__ void pool_item(const bf16* proj, bf16* yp, int g, int row0, int lane) {
#pragma unroll
    for (int sub = 0; sub < 2; ++sub) {
        v4u r[W + 7];
        const GAS v4u* src = (const GAS v4u*)(proj + (size_t)(row0 + 8 * sub) * INW + (ATTW + 2 * KVW) + PGW * g + 8 * lane);
#pragma unroll
        for (int i = 0; i < W + 7; ++i) { const int d = i - (W - 1); if (FIRST && 8 * sub + d < 0) r[i] = (v4u){0u, 0u, 0u, 0u}; else r[i] = src[(long)d * (INW / 8)]; }
        GAS v4u* dst = (GAS v4u*)(yp + (size_t)(row0 + 8 * sub) * POOLW + PGW * g + 8 * lane);
#pragma unroll
        for (int k = 0; k < 8; ++k) {
            float a[8] = {0.f, 0.f, 0.f, 0.f, 0.f, 0.f, 0.f, 0.f};
#pragma unroll
            for (int j = 0; j < W; ++j) { if (FIRST && 8 * sub + k + j < W - 1) continue; const v4u q = r[k + j]; a[0] += bf_lo(q.x); a[1] += bf_hi(q.x); a[2] += bf_lo(q.y); a[3] += bf_hi(q.y); a[4] += bf_lo(q.z); a[5] += bf_hi(q.z); a[6] += bf_lo(q.w); a[7] += bf_hi(q.w); }
            const int cnt = (FIRST && 8 * sub + k + 1 < W) ? (8 * sub + k + 1) : W; const float ic = 1.0f / (float)cnt; const v4u p = r[k + W - 1];
            v4u o; o.x = pk2(a[0] * ic - bf_lo(p.x), a[1] * ic - bf_hi(p.x)); o.y = pk2(a[2] * ic - bf_lo(p.y), a[3] * ic - bf_hi(p.y));
            o.z = pk2(a[4] * ic - bf_lo(p.z), a[5] * ic - bf_hi(p.z)); o.w = pk2(a[6] * ic - bf_lo(p.w), a[7] * ic - bf_hi(p.w));
            dst[(size_t)k * (POOLW / 8)] = o;
        }
        asm volatile("" ::: "memory");
    }
}
template <int W>
__device__ __forceinline__ void pool_item2(const bf16* proj, bf16* yp, int g, int row0, int lane) {
    if ((row0 & (SEQ - 1)) == 0) pool_item<W, true>(proj, yp, g, row0, lane); else pool_item<W, false>(proj, yp, g, row0, lane);
}

constexpr int AT_KROWS = 192, AT_KSTR = 272, AT_VSTR = 392, AT_K_OFF = 0, AT_VT_OFF = AT_KROWS * AT_KSTR;
static_assert(AT_VT_OFF + 128 * AT_VSTR <= RING_BYTES, "attention LDS");
__device__ __forceinline__ void attn_unit(LAS unsigned char* lds, const bf16* proj, bf16* mix, const float* sinks, int unit, int tid, int wid) {
    asm volatile("" : "+v"(tid));
    const int lane = tid & 63;
    const int b = unit >> 7, kvh = (unit >> 5) & 3, qb = unit & 31, q0 = qb * 64, rowbase = b * SEQ;
#pragma unroll
    for (int i = 0; i < 6; ++i) { const int c = tid + 512 * i, key = c >> 4, ch = c & 15; int kp = q0 - 128 + key; kp = kp < 0 ? 0 : kp;
        const v4u v = *(const GAS v4u*)(proj + (size_t)(rowbase + kp) * INW + ATTW + kvh * HD + ch * 8);
        *(LAS v4u*)(lds + AT_K_OFF + key * AT_KSTR + ch * 16) = v; }
#pragma unroll
    for (int i = 0; i < 6; ++i) { const int c = tid + 512 * i, ch = c / 192, key = c - ch * 192; int kp = q0 - 128 + key; kp = kp < 0 ? 0 : kp;
        const v4u v = *(const GAS v4u*)(proj + (size_t)(rowbase + kp) * INW + ATTW + KVW + kvh * HD + ch * 8);
        LAS unsigned short* d = (LAS unsigned short*)(lds + AT_VT_OFF + (ch * 8) * AT_VSTR + key * 2);
        d[0 * (AT_VSTR / 2)] = (unsigned short)(v.x & 0xffffu); d[1 * (AT_VSTR / 2)] = (unsigned short)(v.x >> 16);
        d[2 * (AT_VSTR / 2)] = (unsigned short)(v.y & 0xffffu); d[3 * (AT_VSTR / 2)] = (unsigned short)(v.y >> 16);
        d[4 * (AT_VSTR / 2)] = (unsigned short)(v.z & 0xffffu); d[5 * (AT_VSTR / 2)] = (unsigned short)(v.z >> 16);
        d[6 * (AT_VSTR / 2)] = (unsigned short)(v.w & 0xffffu); d[7 * (AT_VSTR / 2)] = (unsigned short)(v.w >> 16); }
    __syncthreads();
    const int hq = kvh * 4 + (wid >> 1), s = wid & 1, ql = lane & 31, h = lane >> 5;
    const int qrow = rowbase + q0 + 32 * s + ql;
    bf16x8 qf[8];
#pragma unroll
    for (int kk = 0; kk < 8; ++kk) qf[kk] = *(const GAS bf16x8*)(proj + (size_t)qrow * INW + hq * HD + 16 * kk + 8 * h);
    f32x16 sc[5];
#pragma unroll
    for (int kt = 0; kt < 5; ++kt) {
        f32x16 a; for (int r = 0; r < 16; ++r) a[r] = 0.f;
#pragma unroll
        for (int kk = 0; kk < 8; ++kk) { const bf16x8 kf = *(const LAS bf16x8*)(lds + AT_K_OFF + (32 * (s + kt) + ql) * AT_KSTR + (16 * kk + 8 * h) * 2);
            a = __builtin_amdgcn_mfma_f32_32x32x16_bf16(kf, qf[kk], a, 0, 0, 0); }
        sc[kt] = a;
    }
    const float sc2 = 0.08838834764831845f * 1.4426950408889634f;
    const float sink2 = sinks[hq] * 1.4426950408889634f;
    float mx = -__builtin_inff();
    const int tmin = 4 - 2 * qb;
#pragma unroll
    for (int kt = 0; kt < 5; ++kt) {
        const bool tile_ok = (s + kt) >= tmin;
#pragma unroll
        for (int r = 0; r < 16; ++r) { const int koff = (r & 3) + 8 * (r >> 2) + 4 * h;
            bool valid = tile_ok; if (kt == 0) valid = valid && (koff > ql); if (kt == 4) valid = valid && (koff <= ql);
            const float v = valid ? sc[kt][r] * sc2 : -__builtin_inff(); sc[kt][r] = v; mx = fmaxf(mx, v); }
    }
    mx = fmaxf(mx, __shfl_xor(mx, 32)); mx = fmaxf(mx, sink2);
    float sum = 0.f;
#pragma unroll
    for (int kt = 0; kt < 5; ++kt)
#pragma unroll
        for (int r = 0; r < 16; ++r) { const float e = __builtin_amdgcn_exp2f(sc[kt][r] - mx); sc[kt][r] = e; sum += e; }
    sum += __shfl_xor(sum, 32);
    const float inv = 1.0f / (sum + __builtin_amdgcn_exp2f(sink2 - mx));
    f32x16 oacc[4];
#pragma unroll
    for (int dt = 0; dt < 4; ++dt) for (int r = 0; r < 16; ++r) oacc[dt][r] = 0.f;
#pragma unroll
    for (int kt = 0; kt < 5; ++kt)
#pragma unroll
        for (int s2 = 0; s2 < 2; ++s2) {
            v4u pw; pw.x = pg8::cvt_pk_bf16(sc[kt][8 * s2 + 0], sc[kt][8 * s2 + 1]); pw.y = pg8::cvt_pk_bf16(sc[kt][8 * s2 + 2], sc[kt][8 * s2 + 3]);
            pw.z = pg8::cvt_pk_bf16(sc[kt][8 * s2 + 4], sc[kt][8 * s2 + 5]); pw.w = pg8::cvt_pk_bf16(sc[kt][8 * s2 + 6], sc[kt][8 * s2 + 7]);
            const bf16x8 pf = __builtin_bit_cast(bf16x8, pw);
#pragma unroll
            for (int dt = 0; dt < 4; ++dt) { const LAS unsigned char* vb = lds + AT_VT_OFF + (32 * dt + ql) * AT_VSTR + (32 * (s + kt) + 16 * s2 + 4 * h) * 2;
                const v2u lo = *(const LAS v2u*)vb, hi = *(const LAS v2u*)(vb + 16);
                v4u vw; vw.x = lo.x; vw.y = lo.y; vw.z = hi.x; vw.w = hi.y;
                oacc[dt] = __builtin_amdgcn_mfma_f32_32x32x16_bf16(__builtin_bit_cast(bf16x8, vw), pf, oacc[dt], 0, 0, 0); }
        }
    bf16* orow = mix + (size_t)qrow * D + hq * HD;
#pragma unroll
    for (int dt = 0; dt < 4; ++dt)
#pragma unroll
        for (int g4 = 0; g4 < 4; ++g4) { v2u o; o.x = pg8::cvt_pk_bf16(oacc[dt][4 * g4 + 0] * inv, oacc[dt][4 * g4 + 1] * inv); o.y = pg8::cvt_pk_bf16(oacc[dt][4 * g4 + 2] * inv, oacc[dt][4 * g4 + 3] * inv);
            *(GAS v2u*)(orow + 32 * dt + 8 * g4 + 4 * h) = o; }
    __syncthreads();
}

__device__ const double INV_FREQ[64] = {
    1.0, 0.8659643233600653, 0.7498942093324559, 0.6493816315762113, 0.5623413251903491, 0.4869675251658631, 0.4216965034285822, 0.3651741272548377, 0.31622776601683794, 0.27384196342643613, 0.23713737056616552, 0.2053525026457146, 0.1778279410038923, 0.1539926526059492, 0.1333521432163324, 0.11547819846894582,
    0.1, 0.08659643233600653, 0.07498942093324558, 0.06493816315762113, 0.05623413251903491, 0.04869675251658631, 0.042169650342858224, 0.03651741272548377, 0.03162277660168379, 0.027384196342643614, 0.023713737056616554, 0.02053525026457146, 0.01778279410038923, 0.01539926526059492, 0.01333521432163324, 0.011547819846894581,
    0.01, 0.008659643233600654, 0.007498942093324558, 0.006493816315762113, 0.005623413251903491, 0.004869675251658631, 0.004216965034285823, 0.003651741272548377, 0.0031622776601683794, 0.0027384196342643613, 0.0023713737056616554, 0.002053525026457146, 0.0017782794100389228, 0.001539926526059492, 0.001333521432163324, 0.0011547819846894581,
    0.001, 0.0008659643233600654, 0.0007498942093324559, 0.0006493816315762113, 0.0005623413251903491, 0.0004869675251658631, 0.00042169650342858224, 0.0003651741272548377, 0.00031622776601683794, 0.0002738419634264361, 0.00023713737056616554, 0.0002053525026457146, 0.00017782794100389227, 0.0001539926526059492, 0.0001333521432163324, 0.00011547819846894582};
__device__ __forceinline__ void sincos_d(double a, double& sn, double& cs) {
    const double k = __builtin_rint(a * 0.6366197723675814);
    double r = __builtin_fma(-k, 1.5707963267948966, a); r = __builtin_fma(-k, 6.123233995736766e-17, r);
    const double r2 = r * r;
    double sp = -7.647163731819816e-13; sp = sp * r2 + 1.6059043836821613e-10; sp = sp * r2 - 2.505210838544172e-08; sp = sp * r2 + 2.7557319223985893e-06; sp = sp * r2 - 0.0001984126984126984; sp = sp * r2 + 0.008333333333333333; sp = sp * r2 - 0.16666666666666666; sp = r + r * r2 * sp;
    double cp = 4.779477332387385e-14; cp = cp * r2 - 1.1470745597729725e-11; cp = cp * r2 + 2.08767569878681e-09; cp = cp * r2 - 2.755731922398589e-07; cp = cp * r2 + 2.48015873015873e-05; cp = cp * r2 - 0.001388888888888889; cp = cp * r2 + 0.041666666666666664; cp = cp * r2 - 0.5; cp = 1.0 + r2 * cp;
    const int q = ((int)k) & 3;
    sn = (q == 0) ? sp : (q == 1) ? cp : (q == 2) ? -sp : -cp;
    cs = (q == 0) ? cp : (q == 1) ? -sp : (q == 2) ? -cp : sp;
}

struct Args { const float* in[18]; float* out; unsigned char* ws; int ph_lo, ph_hi; };
static_assert(sizeof(Args) == 18 * 8 + 8 + 8 + 8, "Args has no padding");

constexpr int I_G = (D / 64) * (FF / 32), I_D = (FF / 64) * (D / 32), I_IN = (D / 64) * (INW / 32), I_OUT = (D / 64) * (D / 32), I_P = (PGW / 64) * (PGW / 32);
static_assert(I_D == I_G, "items");
constexpr int CV_R0 = 2 * I_G, CV_R1 = CV_R0 + I_D + I_IN, CV_R2 = CV_R1 + I_OUT + 4 * I_P + 2 * I_G, CV_R3 = CV_R2 + I_D;
__device__ __forceinline__ void cvt_any(const Args& args, int it, LAS float* scr, int lane) {
    int r = it, idx, N, ldk, kind = 0, nshift = 0; size_t dst; size_t soff = 0; int f8 = 0;
    if (r < CV_R0) { const int up = r >= I_G; r -= up * I_G; idx = 2 + up; N = FF; ldk = D; dst = WS_WGU1; kind = 1 + up; }
    else if ((r -= CV_R0) < I_D) { idx = 4; N = D; ldk = FF; dst = WS_WD1; }
    else if ((r -= I_D) < I_IN) { idx = 7; N = INW; ldk = D; dst = WS_WIN; kind = 3; }
    else if ((r -= I_IN) < I_OUT) { idx = 11; N = D; ldk = D; dst = WS_WOUT; }
    else if ((r -= I_OUT) < 4 * I_P) { const int gq = r / I_P; r -= gq * I_P; idx = 9; N = PGW; ldk = PGW; dst = WS_WPOOL; soff = (size_t)gq * PGW * PGW; nshift = PGW * gq; }
    else if ((r -= 4 * I_P) < 2 * I_G) { const int up = r >= I_G; r -= up * I_G; idx = 14 + up; N = FF; ldk = D; dst = WS_WGU2; kind = 1 + up; }
    else { r -= 2 * I_G; idx = 16; N = D; ldk = FF; dst = WS_WD2; f8 = FF; }
    const int nblk = N >> 5, kb = r / nblk, nb = r - kb * nblk, n0 = 32 * nb;
    if (idx >= 14 && idx <= 15 && 64 * kb < 128 * P9_N8) f8 = 2 * D;
    const int drow = (kind == 0) ? (nshift + n0) : (kind == 3) ? drow_in(n0) : drow_gu(n0, kind - 1);
    cvt_item(args.in[idx] + soff, N, 64 * kb, n0, (bf16*)(args.ws + dst), ldk, drow, scr, lane, f8);
}
constexpr int CW_Q1 = 1024, CW_Q2 = 1088, CW_Q3 = 1152;

__global__ void __launch_bounds__(NWAVES * 64, 2) hymba_fwd(Args args) {
    extern __shared__ __attribute__((aligned(16))) unsigned char lds_raw[];
    LAS unsigned char* lds = (LAS unsigned char*)lds_raw;
    volatile LAS unsigned* MISC = (volatile LAS unsigned*)(lds + MISC_OFF);
    const int wave = __builtin_amdgcn_readfirstlane((int)threadIdx.x >> 6);
#define PH_IDS const int lane = lane_id_v(), tid = wave * 64 + lane; (void)tid
    const int G = gridDim.x; const int bx = blockIdx.x; const int vcu = (G % 8 == 0) ? (bx % 8) * (G / 8) + bx / 8 : bx;
    const int gw = vcu * NWAVES + wave, NGW = G * NWAVES;
    gu32* ctl = (gu32*)(args.ws + WS_CTL);
#define WSP(T, off) ((T*)(args.ws + (off)))
#define WGU1 WSP(bf16, WS_WGU1)
#define WD1 WSP(bf16, WS_WD1)
#define WIN WSP(bf16, WS_WIN)
#define WOUT WSP(bf16, WS_WOUT)
#define WPOOL WSP(bf16, WS_WPOOL)
#define WGU2 WSP(bf16, WS_WGU2)
#define WD2 WSP(bf16, WS_WD2)
#define XN WSP(bf16, WS_XN)
#define ACT WSP(bf16, WS_ACT)
#define HF WSP(bf16, WS_HF)
#define XRES WSP(bf16, WS_HF + 64 * MiB)
#define PROJ WSP(bf16, WS_PROJ)
#define MIX WSP(bf16, WS_MIX)
#define YP WSP(bf16, WS_YP)
#define COS WSP(float, WS_COS)
#define SIN WSP(float, WS_SIN)
#define XIN (args.in[0])
#define OUTP (args.out)
    LAS float* gA = (LAS float*)(lds + GAIN_OFF); LAS float* gB = (LAS float*)(lds + GAIN_OFF + 16384); LAS float* gC = (LAS float*)(lds + GAIN_OFF - 16384);

    for (int u = threadIdx.x; u < (LDS_BYTES - LDSCTL_OFF) / 4; u += NWAVES * 64) ((LAS unsigned*)(lds + LDSCTL_OFF))[u] = 0u;
    __syncthreads();
    XcdBarrier bar; bar.bar = (unsigned*)(ctl + CW_BAR); bar.x = 0; bar.st = nullptr;
    if (!MK_SPLIT) bar = xcd_barrier_post((unsigned*)(ctl + CW_BAR), MISC + 8);
    const int lo = args.ph_lo, hi = args.ph_hi;
#ifndef REPMASK
#define REPMASK 0
#endif
#define NREP(k) (((REPMASK >> (k)) & 1) ? 2 : 1)
#ifndef PHMASK
#define PHMASK 0xfff
#endif
#define IN(k) (((PHMASK >> (k)) & 1) && lo <= (k) && (k) < hi)
#define SEAM(k) do { if (IN(k) && IN((k) + 1)) xcd_barrier(bar); } while (0)
#define LOAD_GAINS(pa, pb) do { for (int _u = tid; _u < D / 4; _u += NWAVES * 64) { ((LAS f32x4*)gA)[_u] = ((const GAS f32x4*)(pa))[_u]; ((LAS f32x4*)gB)[_u] = ((const GAS f32x4*)(pb))[_u]; } __syncthreads(); } while (0)

#define rsW mk_rsrc(args.ws)
#define rsX mk_rsrc(args.in[0])
#define rsO mk_rsrc(args.out)
#define LOAD_GAINS3(pa, pb, pc) do { for (int _u = tid; _u < D / 4; _u += NWAVES * 64) { ((LAS f32x4*)gA)[_u] = ((const GAS f32x4*)(pa))[_u]; ((LAS f32x4*)gB)[_u] = ((const GAS f32x4*)(pb))[_u]; \
        const f32x4 _g = ((const GAS f32x4*)(pc))[_u]; ((LAS f32x4*)gC)[_u] = (f32x4){__builtin_amdgcn_rcpf(_g.x), __builtin_amdgcn_rcpf(_g.y), __builtin_amdgcn_rcpf(_g.z), __builtin_amdgcn_rcpf(_g.w)}; } __syncthreads(); } while (0)
#define RS0 WSP(float, WS_CTL + 524288)
#define RS1 WSP(float, WS_CTL + 524288 + 65536)
#define CVT_QUEUE(qword, lo_it, hi_it) do { LAS float* scr_ = (LAS float*)(lds + RING_OFF + wave * 8448); \
        for (;;) { if (tid == 0) MISC[0] = (unsigned)(lo_it) + __hip_atomic_fetch_add((unsigned*)(ctl + (qword)), 32u, __ATOMIC_RELAXED, __HIP_MEMORY_SCOPE_AGENT); \
            __syncthreads(); const int base_ = (int)MISC[0]; __syncthreads(); if (base_ >= (hi_it)) break; \
            _Pragma("unroll 1") for (int j_ = 0; j_ < 4; ++j_) { const int it_ = base_ + wave * 4 + j_; if (it_ < (hi_it)) cvt_any(args, it_, scr_, lane); } } } while (0)
    if (IN(0)) for (int rep_ = 0; rep_ < NREP(0); ++rep_) {
        PH_IDS;
        for (int i = gw * 64 + lane; i < SEQ * 64; i += NGW * 64) { const int pos = i >> 6, f = i & 63; double sn, cs; sincos_d((double)pos * INV_FREQ[f], sn, cs); WSP(float, WS_COS)[i] = (float)cs; WSP(float, WS_SIN)[i] = (float)sn; }
        LOAD_GAINS(args.in[1], args.in[1]);
#pragma unroll 1
        for (int m = gw; m < M; m += NGW) norm_row<false, 0, 0, true>(rsW, 0, rsX, m * (D * 4), rsW, 0, rsW, (int)(WS_XN + (size_t)m * (D * 2)), 0.f, gA, gB, lane, nullptr, 0.f, RS0 + m);
        LAS float* scr = (LAS float*)(lds + RING_OFF + wave * 8448);
#pragma unroll 1
        for (int it = gw; it < CV_R0; it += NGW) cvt_any(args, it, scr, lane);
        __syncthreads();
    }
    SEAM(0);
    if (IN(1)) for (int rep_ = 0; rep_ < NREP(1); ++rep_) {
        PH_IDS;
        pg8::Gemm g{XN, WGU1, M, 2 * FF, D, D, D, 0, 0}; pg8::StaticOrder S; S.init(M, 2 * FF, G, bx);
        pg8::EpiSwiGLU<false> E{ACT, FF};
        pg8::gemm_phase<pg8::EpiSwiGLU<false>, pg8::StaticOrder>(lds + RING_OFF, g, S, E, wave, lane);
        if (rep_ == 0) CVT_QUEUE(CW_Q1, CV_R0, CV_R1);
    }
    SEAM(1);
    if (IN(2)) for (int rep_ = 0; rep_ < NREP(2); ++rep_) {
        PH_IDS;
        pg8::Gemm g{ACT, WD1, M, D, FF, FF, FF, 0, 0}; pg8::StaticOrder S; S.init(M, D, G, bx);
        pg8::EpiBf16 E{HF, D, 1.0f};
        pg8::gemm_phase<pg8::EpiBf16, pg8::StaticOrder, false, 2>(lds + RING_OFF, g, S, E, wave, lane);
    }
    SEAM(2);
    if (IN(3)) for (int rep_ = 0; rep_ < NREP(3); ++rep_) {
        PH_IDS;
        LOAD_GAINS3(args.in[5], args.in[6], args.in[1]);
#pragma unroll 1
        for (int m = gw; m < M; m += NGW) norm_row<true, 2, 0, true>(rsW, (int)(WS_HF + (size_t)m * (D * 2)), rsW, (int)(WS_XN + (size_t)m * (D * 2)), rsW, 0, rsW, (int)(WS_XN + (size_t)m * (D * 2)), 0.5f, gA, gB, lane, gC, RS0[m], RS1 + m);
        __syncthreads();
    }
    SEAM(3);
    if (IN(4)) for (int rep_ = 0; rep_ < NREP(4); ++rep_) {
        PH_IDS;
        pg8::Gemm g{XN, WIN, M, INW, D, D, D, 0, 0}; pg8::StaticOrder S; S.init(M, INW, G, bx);
        pg8::EpiInProj E{PROJ, INW, COS, SIN};
        pg8::gemm_phase<pg8::EpiInProj, pg8::StaticOrder, false, 0>(lds + RING_OFF, g, S, E, wave, lane);
        if (rep_ == 0) CVT_QUEUE(CW_Q2, CV_R1, CV_R2);
    }
    SEAM(4);
    if (IN(5)) for (int rep_ = 0; rep_ < NREP(5); ++rep_) {
        PH_IDS;
#pragma unroll 1
        for (int it = gw; it < 4 * (M / 16); it += NGW) { const int gq = it & 3, row0 = (it >> 2) * 16;
            if (gq == 0) pool_item2<2>(PROJ, YP, 0, row0, lane); else if (gq == 1) pool_item2<4>(PROJ, YP, 1, row0, lane);
            else if (gq == 2) pool_item2<8>(PROJ, YP, 2, row0, lane); else pool_item2<16>(PROJ, YP, 3, row0, lane); }
#pragma unroll 1
        for (int un = vcu; un < BATCH * NKV * (SEQ / 64); un += G) attn_unit(lds + RING_OFF, PROJ, MIX, args.in[8], un, tid, wave);
    }
    SEAM(5);
    if (IN(6)) for (int rep_ = 0; rep_ < NREP(6); ++rep_) {
        PH_IDS;
        pg8::Gemm g{YP, WPOOL, M, POOLW, PGW, POOLW, PGW, 1, PGW}; pg8::StaticOrder S; S.init(M, POOLW, G, bx);
        pg8::EpiPool E{MIX + ATTW, D, args.in[10]};
        pg8::gemm_phase<pg8::EpiPool, pg8::StaticOrder>(lds + RING_OFF, g, S, E, wave, lane);
    }
    SEAM(6);
    if (IN(7)) for (int rep_ = 0; rep_ < NREP(7); ++rep_) {
        PH_IDS;
        pg8::Gemm g{MIX, WOUT, M, D, D, D, D, 0, 0}; pg8::StaticOrder S; S.init(M, D, G, bx);
        pg8::EpiBf16 E{HF, D, 1.0f};
        pg8::gemm_phase<pg8::EpiBf16, pg8::StaticOrder, false, 2>(lds + RING_OFF, g, S, E, wave, lane);
    }
    SEAM(7);
    if (IN(8)) for (int rep_ = 0; rep_ < NREP(8); ++rep_) {
        PH_IDS;
        LOAD_GAINS3(args.in[12], args.in[13], args.in[6]);
#pragma unroll 1
        for (int m = gw; m < M; m += NGW) norm_row<true, 2, 2, true, P9_N8 / 2>(rsW, (int)(WS_HF + (size_t)m * (D * 2)), rsW, (int)(WS_XN + (size_t)m * (D * 2)), rsW, (int)((WS_HF + 64 * MiB) + (size_t)m * (D * 2)), rsW, (int)(WS_XN + (size_t)m * (D * 2)), 1.0f, gA, gB, lane, gC, RS1[m]);
        __syncthreads();
    }
    SEAM(8);
    if (IN(9)) for (int rep_ = 0; rep_ < NREP(9); ++rep_) {
        PH_IDS;
        pg8::Gemm g{XN, WGU2, M, 2 * FF, D, D, D, 0, 0}; pg8::StaticOrder S; S.init(M, 2 * FF, G, bx);
        pg8::EpiSwiGLU<true> E{ACT, FF};
        pg8::gemm_phase<pg8::EpiSwiGLU<true>, pg8::StaticOrder, false, P9_PAD, P9_N8>(lds + RING_OFF, g, S, E, wave, lane);
        if (rep_ == 0) CVT_QUEUE(CW_Q3, CV_R2, CV_R3);
    }
    SEAM(9);
    if (IN(10)) for (int rep_ = 0; rep_ < NREP(10); ++rep_) {
        PH_IDS;
        pg8::Gemm g{ACT, WD2, M, D, FF / 2, FF / 2, FF / 2, 0, 0}; pg8::StaticOrder S; S.init(M, D, G, bx);
        pg8::EpiBf16 E{HF, D, 1.0f / 1024.0f};
        pg8::gemm_phase<pg8::EpiBf16, pg8::StaticOrder, true>(lds + RING_OFF, g, S, E, wave, lane);
    }
    SEAM(10);
    if (IN(11)) for (int rep_ = 0; rep_ < NREP(11); ++rep_) {
        PH_IDS;
        LOAD_GAINS(args.in[17], args.in[17]);
#pragma unroll 1
        for (int m = gw; m < M; m += NGW) norm_row<true, 1, 1, false>(rsW, (int)(WS_HF + (size_t)m * (D * 2)), rsW, (int)((WS_HF + 64 * MiB) + (size_t)m * (D * 2)), rsO, m * (D * 4), rsW, 0, 0.5f, gA, gB, lane);
    }
#undef IN
#undef SEAM
#undef LOAD_GAINS
#undef LOAD_GAINS3
#undef CVT_QUEUE
#undef PH_IDS
}

extern "C" void kernel_launch(void* const* d_in, const int* in_sizes, int n_in, void* d_out, int out_size, void* d_ws, size_t ws_size, hipStream_t stream) {
    static int grid = 0;
    if (grid == 0) {
        if (n_in != 18 || in_sizes[0] != M * D || out_size != M * D || ws_size < WS_END) { fprintf(stderr, "kernel_launch: unexpected shapes (n_in %d, in0 %d, out %d, ws %zu, need %zu); nothing launched\n", n_in, n_in > 0 ? in_sizes[0] : -1, out_size, ws_size, (size_t)WS_END); grid = -1; return; }
        int dev = 0, cus = 0, per_cu = 0;
        if (hipGetDevice(&dev) != hipSuccess || hipDeviceGetAttribute(&cus, hipDeviceAttributeMultiprocessorCount, dev) != hipSuccess) { fprintf(stderr, "kernel_launch: device query failed\n"); grid = -1; return; }
        if (hipFuncSetAttribute((const void*)hymba_fwd, hipFuncAttributeMaxDynamicSharedMemorySize, LDS_BYTES) != hipSuccess) { fprintf(stderr, "kernel_launch: hipFuncSetAttribute failed\n"); grid = -1; return; }
        if (hipOccupancyMaxActiveBlocksPerMultiprocessor(&per_cu, (const void*)hymba_fwd, NWAVES * 64, LDS_BYTES) != hipSuccess || per_cu < 1)
            fprintf(stderr, "kernel_launch: note: occupancy query reports %d workgroups per CU\n", per_cu);
        (void)hipGetLastError();
        grid = cus;
    }
    if (grid < 0) return;
    if (hipMemsetAsync((char*)d_ws + WS_CTL, 0, CTL_ZERO_BYTES, stream) != hipSuccess) { fprintf(stderr, "kernel_launch: memset failed\n"); return; }
    Args a{};
    for (int i = 0; i < 18; ++i) a.in[i] = (const float*)d_in[i];
    a.out = (float*)d_out; a.ws = (unsigned char*)d_ws;
#if MK_SPLIT
    for (int p = 0; p < N_PHASES; ++p) { a.ph_lo = p; a.ph_hi = p + 1; hipLaunchKernelGGL(hymba_fwd, dim3(grid), dim3(NWAVES * 64), LDS_BYTES, stream, a); }
#else
    a.ph_lo = 0; a.ph_hi = N_PHASES;
    hipLaunchKernelGGL(hymba_fwd, dim3(grid), dim3(NWAVES * 64), LDS_BYTES, stream, a);
#endif
    const hipError_t le = hipPeekAtLastError();
    if (le != hipSuccess) fprintf(stderr, "kernel_launch: launch failed: %s\n", hipGetErrorName(le));
}
```
